# Optimizing an MI355X kernel written in HIP

```python
import math
import jax, jax.numpy as jnp
from jax import lax
import numpy as np

D_MODEL = 1024
BATCH = 8
SEQ = 4096
DEPTH = 1


GRID_W = 64
CTX_LEN = 256
N_MOD = 6
RMS_EPS = 1e-6

D_RNN = D_MODEL
RNN_HEADS = 16
RNN_HEAD_DIM = D_RNN // RNN_HEADS
RNN_CONV_W = 4
RNN_CONV_PAD = (2, 1)
RG_C = 8.0

D_HY = D_MODEL
HY_ORDER = 2
HY_CONV_W = 3
HY_CONV_PAD = (1, 1)
HY_EMB = 33
HY_BANDS = (HY_EMB - 1) // 2
HY_FILTER_ORDER = 64
HY_FAST_DECAY = 0.3
HY_SLOW_DECAY = 1.5
HY_TARGET = 1e-2

D_FF = ((8 * D_MODEL // 3 + 255) // 256) * 256

D_IN = 2 * D_RNN + 3 * D_HY + 2 * D_MODEL

kernel_name = 'hybrid_rglru_hyena_dit_block'


def rms_norm(x, g):
    xf = x.astype(jnp.float32)
    y = xf * lax.rsqrt(jnp.mean(xf * xf, axis=-1, keepdims=True) + RMS_EPS)
    return (y * g.astype(jnp.float32)).astype(x.dtype)


def modulate(h, shift, scale):
    return h * (1.0 + scale) + shift


def short_conv(u, w, b, pad):
    L = u.shape[-2]
    widths = [(0, 0)] * (u.ndim - 2) + [pad, (0, 0)]
    up = jnp.pad(u, widths)
    out = b
    for k in range(w.shape[0]):
        out = out + up[..., k:k + L, :] * w[k]
    return out


def seq_conv(u, w, b, pad, grid):
    if grid:
        B, T, C = u.shape
        rows = T // GRID_W
        return short_conv(u.reshape(B, rows, GRID_W, C), w, b, pad).reshape(B, T, C)
    return short_conv(u, w, b, pad)


def linear_scan(a, b, h0):
    def combine(e1, e2):
        a1, b1 = e1
        a2, b2 = e2
        return a1 * a2, a2 * b1 + b2
    A, H = lax.associative_scan(combine, (a, b), axis=1)
    return H + A * h0[:, None, :]


def rglru(u, wa, ba, wx, bx, lam, h0_f, h0_b):
    B, L, _ = u.shape
    uh = u.reshape(B, L, RNN_HEADS, RNN_HEAD_DIM)
    r = jax.nn.sigmoid(jnp.einsum('blhi,dhij->dblhj', uh, wa.astype(jnp.float32)).reshape(2, B, L, D_RNN)
                       + ba.astype(jnp.float32)[:, None, None, :])
    i = jax.nn.sigmoid(jnp.einsum('blhi,dhij->dblhj', uh, wx.astype(jnp.float32)).reshape(2, B, L, D_RNN)
                       + bx.astype(jnp.float32)[:, None, None, :])
    log_a = -RG_C * r * jax.nn.softplus(-lam.astype(jnp.float32))[:, None, None, :]
    a = jnp.exp(log_a)
    bb = jnp.sqrt(-jnp.expm1(2.0 * log_a)) * (i * u[None])
    h_f = linear_scan(a[0], bb[0], h0_f)
    h_b = jnp.flip(linear_scan(jnp.flip(a[1], 1), jnp.flip(bb[1], 1), h0_b), 1)
    return h_f, h_b


def hyena_filters(L, lp):
    f32 = jnp.float32
    t = jnp.linspace(0.0, 1.0, L, dtype=f32)[:, None]
    w = 2.0 * math.pi * jnp.arange(L, dtype=f32)[:, None] / L
    f = jnp.linspace(1e-4, HY_BANDS - 1, HY_BANDS, dtype=f32)[None, :]
    z = jnp.concatenate([t, jnp.cos(f * w), -jnp.sin(f * w)], axis=-1)
    freq = lp['hy_freq'].astype(f32)
    hdn = jnp.sin(freq * (z @ lp['hy_w1'].astype(f32) + lp['hy_b1'].astype(f32)))
    hdn = jnp.sin(freq * (hdn @ lp['hy_w2'].astype(f32) + lp['hy_b2'].astype(f32)))
    hdn = jnp.sin(freq * (hdn @ lp['hy_w3'].astype(f32) + lp['hy_b3'].astype(f32)))
    k = (hdn @ lp['hy_w4'].astype(f32)).reshape(L, HY_ORDER, 2, D_HY)
    max_decay = math.log(HY_TARGET) / HY_FAST_DECAY
    min_decay = math.log(HY_TARGET) / HY_SLOW_DECAY
    deltas = jnp.abs(jnp.linspace(min_decay, max_decay, D_HY, dtype=f32))
    k = k * jnp.exp(-t[:, :, None, None] * deltas)
    fwd, bwd = k[:, :, 0], k[:, :, 1]
    full = jnp.concatenate([fwd, jnp.zeros((1, HY_ORDER, D_HY), f32), jnp.flip(bwd[1:], 0)], axis=0)
    return full / jnp.sum(jnp.abs(full), axis=0, keepdims=True)


def hyena(phy, lp, grid):
    q = seq_conv(phy, lp['hy_conv_w'], lp['hy_conv_b'], HY_CONV_PAD, grid).astype(jnp.float32)
    v, x1, x2 = jnp.split(q, 3, axis=-1)
    L = q.shape[1]
    k_f = jnp.fft.rfft(hyena_filters(L, lp), axis=0)
    skip = lp['hy_skip'].astype(jnp.float32)
    z = v
    for o, gate in enumerate((x1, x2)):
        z_f = jnp.fft.rfft(z, n=2 * L, axis=1)
        conv = jnp.fft.irfft(z_f * k_f[None, :, o], n=2 * L, axis=1)[:, :L]
        z = gate * (conv + skip[o] * z)
    return z


def rnn_states(h, lp, grid, h0_f, h0_b):
    rx = h @ lp['w_in'][:, :D_RNN] + lp['b_in'][:D_RNN]
    u = seq_conv(rx, lp['rnn_conv_w'], lp['rnn_conv_b'], RNN_CONV_PAD, grid).astype(jnp.float32)
    return rglru(u, lp['rg_wa'], lp['rg_ba'], lp['rg_wx'], lp['rg_bx'], lp['rg_lambda'], h0_f, h0_b)


def mixer(h, lp, grid, h0_f, h0_b):
    h_f, h_b = rnn_states(h, lp, grid, h0_f, h0_b)
    rest = h @ lp['w_in'][:, D_RNN:] + lp['b_in'][D_RNN:]
    rg = rest[..., :D_RNN]
    phy = rest[..., D_RNN:D_RNN + 3 * D_HY]
    bg = rest[..., D_RNN + 3 * D_HY:]
    y_rnn = ((h_f + h_b) * jax.nn.gelu(rg.astype(jnp.float32))).astype(h.dtype)
    y_hy = hyena(phy, lp, grid).astype(h.dtype)
    g_a, g_b = jnp.split(jax.nn.sigmoid(bg), 2, axis=-1)
    merged = g_a * (y_rnn @ lp['w_a_out']) + g_b * (y_hy @ lp['w_b_out'])
    return merged @ lp['w_out'], h_f[:, -1], h_b[:, 0]


def swiglu(h, lp):
    g, u = jnp.split(h @ lp['w_ffn_in'], 2, axis=-1)
    return (jax.nn.silu(g) * u) @ lp['w_ffn_out']


def block(x, ctx, c, c_ctx, lp, update_ctx):
    mod = jax.nn.silu(c) @ lp['w_mod'] + lp['b_mod']
    mod_c = jax.nn.silu(c_ctx) @ lp['w_mod'] + lp['b_mod']
    sh1, sc1, g1, sh2, sc2, g2 = jnp.split(mod[:, None, :], N_MOD, axis=-1)
    csh1, csc1, cg1, csh2, csc2, cg2 = jnp.split(mod_c, N_MOD, axis=-1)
    B = x.shape[0]
    zeros = jnp.zeros((B, D_RNN), jnp.float32)
    hc = modulate(rms_norm(ctx, lp['norm1_g']), csh1, csc1)
    if update_ctx:
        yc, cf, cb = mixer(hc, lp, False, zeros, zeros)
        ctx = ctx + cg1 * yc
        ctx = ctx + cg2 * swiglu(modulate(rms_norm(ctx, lp['norm2_g']), csh2, csc2), lp)
    else:
        hcf, hcb = rnn_states(hc, lp, False, zeros, zeros)
        cf, cb = hcf[:, -1], hcb[:, 0]
    hx = modulate(rms_norm(x, lp['norm1_g']), sh1, sc1)
    yx, _, _ = mixer(hx, lp, True, cf, cb)
    x = x + g1 * yx
    x = x + g2 * swiglu(modulate(rms_norm(x, lp['norm2_g']), sh2, sc2), lp)
    return x, ctx


def setup_inputs(seed: int = 0) -> dict:
    key = jax.random.key(seed)
    ks = jax.random.split(key, 40)
    f32 = jnp.float32

    def nrm(k, shape, scale):
        return jax.random.normal(k, shape, f32) * scale

    u = jax.random.uniform(ks[16], (DEPTH, 2, D_RNN), f32, minval=0.9, maxval=0.999)
    a0 = u ** (1.0 / RG_C)
    return {
        'x': nrm(ks[0], (BATCH, SEQ, D_MODEL), 1.0),
        'c': nrm(ks[1], (BATCH, D_MODEL), 1.0),
        'ctx': nrm(ks[2], (BATCH, CTX_LEN, D_MODEL), 1.0),
        'c_ctx': nrm(ks[3], (D_MODEL,), 1.0),
        'w_mod': nrm(ks[4], (DEPTH, D_MODEL, N_MOD * D_MODEL), D_MODEL ** -0.5),
        'b_mod': nrm(ks[5], (DEPTH, N_MOD * D_MODEL), 0.02),
        'norm1_g': 1.0 + nrm(ks[6], (DEPTH, D_MODEL), 0.02),
        'norm2_g': 1.0 + nrm(ks[7], (DEPTH, D_MODEL), 0.02),
        'w_in': nrm(ks[8], (DEPTH, D_MODEL, D_IN), D_MODEL ** -0.5),
        'b_in': nrm(ks[9], (DEPTH, D_IN), 0.02),
        'rnn_conv_w': nrm(ks[10], (DEPTH, RNN_CONV_W, D_RNN), RNN_CONV_W ** -0.5),
        'rnn_conv_b': nrm(ks[11], (DEPTH, D_RNN), 0.02),
        'rg_wa': nrm(ks[12], (DEPTH, 2, RNN_HEADS, RNN_HEAD_DIM, RNN_HEAD_DIM), RNN_HEAD_DIM ** -0.5),
        'rg_ba': nrm(ks[13], (DEPTH, 2, D_RNN), 0.02),
        'rg_wx': nrm(ks[14], (DEPTH, 2, RNN_HEADS, RNN_HEAD_DIM, RNN_HEAD_DIM), RNN_HEAD_DIM ** -0.5),
        'rg_bx': nrm(ks[15], (DEPTH, 2, D_RNN), 0.02),
        'rg_lambda': jnp.log(a0) - jnp.log1p(-a0),
        'hy_conv_w': nrm(ks[17], (DEPTH, HY_CONV_W, 3 * D_HY), HY_CONV_W ** -0.5),
        'hy_conv_b': nrm(ks[18], (DEPTH, 3 * D_HY), 0.02),
        'hy_w1': nrm(ks[19], (DEPTH, HY_EMB, HY_FILTER_ORDER), HY_EMB ** -0.5),
        'hy_b1': nrm(ks[20], (DEPTH, HY_FILTER_ORDER), 0.1),
        'hy_w2': nrm(ks[21], (DEPTH, HY_FILTER_ORDER, HY_FILTER_ORDER), HY_FILTER_ORDER ** -0.5),
        'hy_b2': nrm(ks[22], (DEPTH, HY_FILTER_ORDER), 0.1),
        'hy_w3': nrm(ks[23], (DEPTH, HY_FILTER_ORDER, HY_FILTER_ORDER), HY_FILTER_ORDER ** -0.5),
        'hy_b3': nrm(ks[24], (DEPTH, HY_FILTER_ORDER), 0.1),
        'hy_freq': 1.0 + nrm(ks[25], (DEPTH, HY_FILTER_ORDER), 0.01),
        'hy_w4': nrm(ks[26], (DEPTH, HY_FILTER_ORDER, HY_ORDER * 2 * D_HY), HY_FILTER_ORDER ** -0.5),
        'hy_skip': nrm(ks[27], (DEPTH, HY_ORDER, D_HY), 1.0),
        'w_a_out': nrm(ks[28], (DEPTH, D_RNN, D_MODEL), D_RNN ** -0.5),
        'w_b_out': nrm(ks[29], (DEPTH, D_HY, D_MODEL), D_HY ** -0.5),
        'w_out': nrm(ks[30], (DEPTH, D_MODEL, D_MODEL), D_MODEL ** -0.5),
        'w_ffn_in': nrm(ks[31], (DEPTH, D_MODEL, 2 * D_FF), D_MODEL ** -0.5),
        'w_ffn_out': nrm(ks[32], (DEPTH, D_FF, D_MODEL), D_FF ** -0.5),
        'final_g': 1.0 + nrm(ks[33], (D_MODEL,), 0.02),
    }


def reference(x, c, ctx, c_ctx, w_mod, b_mod, norm1_g, norm2_g, w_in, b_in, rnn_conv_w, rnn_conv_b,
              rg_wa, rg_ba, rg_wx, rg_bx, rg_lambda, hy_conv_w, hy_conv_b, hy_w1, hy_b1, hy_w2, hy_b2,
              hy_w3, hy_b3, hy_freq, hy_w4, hy_skip, w_a_out, w_b_out, w_out, w_ffn_in, w_ffn_out, final_g):
    for l in range(DEPTH):
        lp = dict(w_mod=w_mod[l], b_mod=b_mod[l], norm1_g=norm1_g[l], norm2_g=norm2_g[l],
                  w_in=w_in[l], b_in=b_in[l], rnn_conv_w=rnn_conv_w[l], rnn_conv_b=rnn_conv_b[l],
                  rg_wa=rg_wa[l], rg_ba=rg_ba[l], rg_wx=rg_wx[l], rg_bx=rg_bx[l], rg_lambda=rg_lambda[l],
                  hy_conv_w=hy_conv_w[l], hy_conv_b=hy_conv_b[l], hy_w1=hy_w1[l], hy_b1=hy_b1[l],
                  hy_w2=hy_w2[l], hy_b2=hy_b2[l], hy_w3=hy_w3[l], hy_b3=hy_b3[l], hy_freq=hy_freq[l],
                  hy_w4=hy_w4[l], hy_skip=hy_skip[l], w_a_out=w_a_out[l], w_b_out=w_b_out[l],
                  w_out=w_out[l], w_ffn_in=w_ffn_in[l], w_ffn_out=w_ffn_out[l])
        x, ctx = block(x, ctx, c, c_ctx, lp, l < DEPTH - 1)
    return rms_norm(x, final_g)
```

```cpp
#include <hip/hip_runtime.h>
#include <cstdio>
#include <cstdint>
#include <cmath>
namespace pg8 {
#define PG8_LAS __attribute__((address_space(3)))
typedef unsigned short bf16_t;
typedef short bf16x8 __attribute__((ext_vector_type(8)));
typedef float f32x4 __attribute__((ext_vector_type(4)));
typedef unsigned u32x4 __attribute__((ext_vector_type(4)));
constexpr int BM = 256, BK = 64, HALF = 128, HTB = HALF * BK * 2  , STAGE_BYTES = 8 * HTB, NXCD = 8, WGM = 8;

__host__ __device__ __forceinline__ int lds_byte(int r, int c) { const int st = (r >> 4) * 2 + (c >> 5), rr = r & 15, cc = c & 31, ob = rr * 64 + cc * 2; return st * 1024 + (ob ^ (((ob >> 9) & 1) << 5)); }
__host__ __device__ __forceinline__ void stage_rc(int b, int& R, int& C) { const int st = b / 1024, sb = b % 1024, swz = sb ^ (((sb >> 9) & 1) << 5); R = (st >> 1) * 16 + swz / 64; C = (st & 1) * 32 + (swz % 64) / 2; }
__host__ __device__ __forceinline__ int perm32(int rho) { const int n = rho >> 4, i = rho & 15; return 8 * (i >> 2) + 4 * n + (i & 3); }

struct Unit { int pm, pn, sel; };
struct Gemm { const bf16_t* A; const bf16_t* Bt; const bf16_t* A1; const bf16_t* Bt1; int M, N, K; };

struct StaticOrder {
    int nM, nN, nwg, G, c;
    __host__ __device__ __forceinline__ void init(int M, int N, int G_, int c_) { nM = M / BM; nN = N / BM; nwg = nM * nN; G = G_; c = c_; }
    __host__ __device__ __forceinline__ bool next(int i, Unit& u) const {
        const long L = (long)i * G + c; if (L >= nwg) return false;
        int wgid = (int)L; { const int q = nwg / NXCD, r = nwg % NXCD, xcd = wgid % NXCD, off = wgid / NXCD; wgid = (xcd < r ? xcd * (q + 1) : r * (q + 1) + (xcd - r) * q) + off; }
        const int nig = WGM * nN, gid = wgid / nig, fm = gid * WGM, gsz = (nM - fm) < WGM ? (nM - fm) : WGM;
        u.pm = fm + ((wgid % nig) % gsz); u.pn = (wgid % nig) / gsz; u.sel = 0; return true;
    }
    __device__ __forceinline__ void a_ready(const Unit&) const {}
    __device__ __forceinline__ void done(const Unit&) const {}
};


__device__ __forceinline__ unsigned cvt_pk_bf16(float lo, float hi) { unsigned r; asm volatile("v_cvt_pk_bf16_f32 %0, %1, %2" : "=v"(r) : "v"(lo), "v"(hi)); return r; }
template <class Epi, class Sched, bool ALIGN_EPI = false, bool SP2 = false>
__device__ __forceinline__ void gemm_phase(PG8_LAS unsigned char* lds, const Gemm g, const Sched& S, const Epi& E) {
    const int tid = threadIdx.x, wid = __builtin_amdgcn_readfirstlane(tid >> 6), lane = tid & 63, wr = wid >> 2, wc = wid & 3, fr = lane & 15, fq = lane >> 4;
    const int K = g.K, nt = K / BK;
    unsigned voffA[2], voffB[2];
#pragma unroll
    for (int i = 0; i < 2; ++i) { int R, C; stage_rc(tid * 16 + i * 8192, R, C); const int Rb = Epi::PERM ? ((R & ~31) + perm32(R & 31)) : R;
        voffA[i] = (unsigned)(R * K + C) * 2u; voffB[i] = (unsigned)(Rb * K + C) * 2u; }
    const size_t kstep = (size_t)(BK * 2);
    const size_t hstep = (size_t)HALF * K * 2;
    const size_t tstep = 2 * hstep;
    const unsigned ldsw = (unsigned)wid * 1024u;
    const int aoff = lds_byte(wr * 64 + fr, fq * 8), boff = lds_byte(wc * 32 + fr, fq * 8);
#define PG8_SA(b, h) (((b) * 2 + (h)) * HTB)
#define PG8_SB(b, h) ((4 + (b) * 2 + (h)) * HTB)
#define PG8_STAGE(bufoff, gbase, voff) do { _Pragma("unroll") for (int _i = 0; _i < 2; ++_i) \
        __builtin_amdgcn_global_load_lds((const unsigned*)((const char*)(gbase) + (voff)[_i]), (PG8_LAS unsigned*)(lds + (bufoff) + ldsw + _i * 8192), 16, 0, 0); } while (0)
#define PG8_LDA(dst, b, h) do { _Pragma("unroll") for (int m = 0; m < 4; ++m) _Pragma("unroll") for (int k = 0; k < 2; ++k) dst[m][k] = *(const PG8_LAS bf16x8*)(lds + PG8_SA(b, h) + aoff + m * 2048 + k * 1024); } while (0)
#define PG8_LDB(dst, b, h) do { _Pragma("unroll") for (int n = 0; n < 2; ++n) _Pragma("unroll") for (int k = 0; k < 2; ++k) dst[n][k] = *(const PG8_LAS bf16x8*)(lds + PG8_SB(b, h) + boff + n * 2048 + k * 1024); } while (0)
#define PG8_MMA(ai, bj, At, Bt) do { __builtin_amdgcn_s_setprio(1); _Pragma("unroll") for (int m = 0; m < 4; ++m) _Pragma("unroll") for (int n = 0; n < 2; ++n) _Pragma("unroll") for (int k = 0; k < 2; ++k) \
        acc[ai][bj][m][n] = __builtin_amdgcn_mfma_f32_16x16x32_bf16(Bt[n][k], At[m][k], acc[ai][bj][m][n], 0, 0, 0); __builtin_amdgcn_s_setprio(0); } while (0)
#define PG8_WAIT_V(n) asm volatile("s_waitcnt vmcnt(" #n ")" ::: "memory")
#define PG8_WAIT_L(n) asm volatile("s_waitcnt lgkmcnt(" #n ")" ::: "memory")
#define PG8_BAR __builtin_amdgcn_s_barrier()
#define PG8_SCHED __builtin_amdgcn_sched_barrier(0)
    Unit cur, nxt; int ui = 0;
    if (!S.next(0, cur)) return;
    f32x4 acc[2][2][4][2];
#pragma unroll
    for (int a = 0; a < 2; ++a)
#pragma unroll
        for (int b = 0; b < 2; ++b)
#pragma unroll
            for (int m = 0; m < 4; ++m)
#pragma unroll
                for (int n = 0; n < 2; ++n) acc[a][b][m][n] = (f32x4){0.f, 0.f, 0.f, 0.f};
    bf16x8 At[4][2], B0[2][2], B1[2][2];
    const char* cA = (const char*)(cur.sel ? g.A1 : g.A) + (size_t)cur.pm * tstep; const char* cB = (const char*)(cur.sel ? g.Bt1 : g.Bt) + (size_t)cur.pn * tstep;
    S.a_ready(cur);
    if constexpr (SP2) {
        PG8_STAGE(PG8_SB(0, 0), cB, voffB); PG8_STAGE(PG8_SB(0, 1), cB + hstep, voffB); PG8_STAGE(PG8_SA(0, 0), cA, voffA); PG8_STAGE(PG8_SA(0, 1), cA + hstep, voffA);
        if (wr == 1) PG8_BAR;
        PG8_WAIT_V(2); PG8_BAR;
        PG8_STAGE(PG8_SB(1, 0), cB + kstep, voffB); PG8_STAGE(PG8_SA(1, 0), cA + kstep, voffA); PG8_STAGE(PG8_SB(1, 1), cB + hstep + kstep, voffB);
        PG8_WAIT_V(6); PG8_BAR;
    } else {
        PG8_STAGE(PG8_SB(0, 0), cB, voffB); PG8_STAGE(PG8_SA(0, 0), cA, voffA); PG8_STAGE(PG8_SB(0, 1), cB + hstep, voffB); PG8_STAGE(PG8_SA(0, 1), cA + hstep, voffA);
        if (wr == 1) PG8_BAR;
        PG8_WAIT_V(4); PG8_BAR;
        PG8_STAGE(PG8_SB(1, 0), cB + kstep, voffB); PG8_STAGE(PG8_SA(1, 0), cA + kstep, voffA); PG8_STAGE(PG8_SB(1, 1), cB + hstep + kstep, voffB);
        PG8_WAIT_V(6); PG8_BAR;
    }
    for (;;) {
        const bool has_next = S.next(ui + 1, nxt);
        const char* nA = has_next ? (const char*)(nxt.sel ? g.A1 : g.A) + (size_t)nxt.pm * tstep : cA; const char* nB = has_next ? (const char*)(nxt.sel ? g.Bt1 : g.Bt) + (size_t)nxt.pn * tstep : cB;
        for (int t = 0; t < nt; t += 2) {
            const bool last = (t == nt - 2);
            const char* a1 = cA + (size_t)(t + 1) * kstep;
            const char* a2 = last ? nA : cA + (size_t)(t + 2) * kstep; const char* b2 = last ? nB : cB + (size_t)(t + 2) * kstep;
            const char* a3 = a2 + kstep; const char* b3 = b2 + kstep;
            if (last && has_next) S.a_ready(nxt);
            if constexpr (SP2) {
            PG8_LDB(B0, 0, 0); PG8_LDB(B1, 0, 1); PG8_SCHED; PG8_LDA(At, 0, 0); PG8_STAGE(PG8_SA(1, 1), a1 + hstep, voffA);
            PG8_WAIT_V(8); PG8_WAIT_L(0); PG8_BAR; PG8_MMA(0, 0, At, B0); PG8_MMA(0, 1, At, B1); PG8_BAR; PG8_SCHED;
            PG8_LDA(At, 0, 1); PG8_STAGE(PG8_SB(0, 0), b2, voffB); PG8_STAGE(PG8_SB(0, 1), b2 + hstep, voffB); PG8_STAGE(PG8_SA(0, 0), a2, voffA);
            PG8_WAIT_V(8); PG8_WAIT_L(0); PG8_BAR; PG8_MMA(1, 0, At, B0); PG8_MMA(1, 1, At, B1); PG8_BAR; PG8_SCHED;
            PG8_LDB(B0, 1, 0); PG8_LDB(B1, 1, 1); PG8_SCHED; PG8_LDA(At, 1, 0); PG8_STAGE(PG8_SA(0, 1), a2 + hstep, voffA);
            PG8_WAIT_V(8); PG8_WAIT_L(0); PG8_BAR; PG8_MMA(0, 0, At, B0); PG8_MMA(0, 1, At, B1); PG8_BAR; PG8_SCHED;
            PG8_LDA(At, 1, 1); PG8_STAGE(PG8_SB(1, 0), b3, voffB); PG8_STAGE(PG8_SB(1, 1), b3 + hstep, voffB); PG8_STAGE(PG8_SA(1, 0), a3, voffA);
            PG8_WAIT_V(8); PG8_WAIT_L(0); PG8_BAR; PG8_MMA(1, 0, At, B0); PG8_MMA(1, 1, At, B1); PG8_BAR; PG8_SCHED;
            } else {
            PG8_LDB(B0, 0, 0); PG8_SCHED; PG8_LDA(At, 0, 0); PG8_STAGE(PG8_SA(1, 1), a1 + hstep, voffA);
            PG8_WAIT_L(8); PG8_BAR; PG8_WAIT_L(0); PG8_MMA(0, 0, At, B0); PG8_BAR; PG8_SCHED;
            PG8_LDB(B1, 0, 1); PG8_STAGE(PG8_SB(0, 0), b2, voffB);
            PG8_BAR; PG8_WAIT_L(0); PG8_MMA(0, 1, At, B1); PG8_BAR;
            PG8_LDA(At, 0, 1); PG8_STAGE(PG8_SA(0, 0), a2, voffA);
            PG8_BAR; PG8_WAIT_L(0); PG8_MMA(1, 0, At, B0); PG8_BAR; PG8_SCHED;
            PG8_STAGE(PG8_SB(0, 1), b2 + hstep, voffB);
            PG8_WAIT_V(6); PG8_BAR; PG8_MMA(1, 1, At, B1); PG8_BAR;
            PG8_LDB(B0, 1, 0); PG8_SCHED; PG8_LDA(At, 1, 0); PG8_STAGE(PG8_SA(0, 1), a2 + hstep, voffA);
            PG8_WAIT_L(8); PG8_BAR; PG8_WAIT_L(0); PG8_MMA(0, 0, At, B0); PG8_BAR; PG8_SCHED;
            PG8_LDB(B1, 1, 1); PG8_STAGE(PG8_SB(1, 0), b3, voffB);
            PG8_BAR; PG8_WAIT_L(0); PG8_MMA(0, 1, At, B1); PG8_BAR;
            PG8_LDA(At, 1, 1); PG8_STAGE(PG8_SA(1, 0), a3, voffA);
            PG8_BAR; PG8_WAIT_L(0); PG8_MMA(1, 0, At, B0); PG8_BAR; PG8_SCHED;
            PG8_STAGE(PG8_SB(1, 1), b3 + hstep, voffB);
            PG8_WAIT_V(6); PG8_BAR; PG8_MMA(1, 1, At, B1); PG8_BAR;
            }
        }
        if constexpr (ALIGN_EPI) { if (wr == 0) PG8_BAR; }
        if constexpr (!Epi::AFTER_DRAIN) { E(acc, cur, wr, wc, fr, fq); S.done(cur); }
        if (!has_next) break;
#pragma unroll
        for (int a = 0; a < 2; ++a)
#pragma unroll
            for (int b = 0; b < 2; ++b)
#pragma unroll
                for (int m = 0; m < 4; ++m)
#pragma unroll
                    for (int n = 0; n < 2; ++n) acc[a][b][m][n] = (f32x4){0.f, 0.f, 0.f, 0.f};
        cur = nxt; cA = nA; cB = nB; ++ui;
        if constexpr (ALIGN_EPI) { if (wr == 1) PG8_BAR; }
    }
    PG8_WAIT_V(0);
    if constexpr (!ALIGN_EPI) { if (wr == 0) PG8_BAR; }
    PG8_BAR;
    if constexpr (Epi::AFTER_DRAIN) { E.fused(acc, cur, wr, wc, fr, fq, lds, wid, lane); S.done(cur); }
#undef PG8_SA
#undef PG8_SB
#undef PG8_STAGE
#undef PG8_LDA
#undef PG8_LDB
#undef PG8_MMA
#undef PG8_WAIT_V
#undef PG8_WAIT_L
#undef PG8_BAR
#undef PG8_SCHED
}
}

#define GAS __attribute__((address_space(1)))
#define LAS __attribute__((address_space(3)))
typedef unsigned short bf16;
typedef unsigned v4u __attribute__((ext_vector_type(4)));
typedef float f32x4 __attribute__((ext_vector_type(4)));
typedef short bf16x8 __attribute__((ext_vector_type(8)));
typedef GAS unsigned gu32;
typedef GAS unsigned long long gu64;
#define RLX_AGENT __ATOMIC_RELAXED, __HIP_MEMORY_SCOPE_AGENT
#define LDS_WAIT() asm volatile("s_waitcnt lgkmcnt(0)" ::: "memory")
#define VM_WAIT() asm volatile("s_waitcnt vmcnt(0)" ::: "memory")
__device__ __forceinline__ unsigned long long rt() { return __builtin_amdgcn_s_memrealtime(); }
__device__ __forceinline__ unsigned f2bf(float f) { unsigned u = __builtin_bit_cast(unsigned, f); return (u + 0x7fffu + ((u >> 16) & 1u)) >> 16; }
__device__ __forceinline__ unsigned pk2(float lo, float hi) { return f2bf(lo) | (f2bf(hi) << 16); }

#define XB_TMO      128
#define XB_XCNT(j)  (256  + 64 * (j))
#define XB_XSUB(j)  (1280 + 64 * (j))
#define XB_XGEN(j)  (2304 + 64 * (j))
#define XB_TOP      3328
#define XB_TOPGEN   3392
#define XCD_BAR_WORDS 3456
#define XB_SPIN_CAP (1u << 18)

__device__ __forceinline__ unsigned xb_ld(unsigned* p)              { return __hip_atomic_load(p, __ATOMIC_RELAXED, __HIP_MEMORY_SCOPE_AGENT); }
__device__ __forceinline__ unsigned xb_add(unsigned* p, unsigned v) { return __hip_atomic_fetch_add(p, v, __ATOMIC_RELAXED, __HIP_MEMORY_SCOPE_AGENT); }
__device__ __forceinline__ unsigned xb_xcc_id() { return (unsigned)__builtin_amdgcn_s_getreg((3 << 11) | 20) & 0xFu; }
#define XB_SPIN(cond, bar) do { unsigned _sp = 0; while (cond) { __builtin_amdgcn_s_sleep(1); \
    if ((++_sp & 255u) == 0u) { if (xb_ld(&(bar)[XB_TMO])) break; if (_sp > XB_SPIN_CAP) { atomicAdd(&(bar)[XB_TMO], 1u); break; } } } } while (0)

struct XcdBarrier {
    unsigned* bar; unsigned x;
    volatile LAS unsigned* st;
};

__device__ __forceinline__ XcdBarrier xcd_barrier_post(unsigned* bar, volatile LAS unsigned* st) {
    XcdBarrier b; b.bar = bar; b.x = xb_xcc_id(); b.st = st;
    if (threadIdx.x == 0) (void)xb_add(&bar[XB_XCNT(b.x)], 1u);
    return b;
}
__device__ __forceinline__ void xcd_barrier_complete(unsigned* bar, unsigned x, unsigned& nloc, unsigned& nx) {
    const unsigned G = gridDim.x * gridDim.y * gridDim.z;
    unsigned sum, cnt, mine, sp = 0u;
    for (;;) {
        sum = 0u; cnt = 0u; mine = 0u;
#pragma unroll
        for (unsigned j = 0; j < 16; ++j) { const unsigned c = xb_ld(&bar[XB_XCNT(j)]); sum += c; cnt += (c > 0u) ? 1u : 0u; mine = (j == x) ? c : mine; }
        if (sum == G) break;
        __builtin_amdgcn_s_sleep(1);
        if ((++sp & 255u) == 0u) { if (xb_ld(&bar[XB_TMO])) break; if (sp > XB_SPIN_CAP) { atomicAdd(&bar[XB_TMO], 1u); break; } }
    }
    nloc = mine > 0u ? mine : 1u; nx = cnt > 0u ? cnt : 1u;
}

__device__ __forceinline__ void xcd_barrier(const XcdBarrier& b) {
    asm volatile("s_waitcnt vmcnt(0)" ::: "memory");
    __syncthreads();
    if (threadIdx.x == 0) {
        unsigned* bar = b.bar;
        __builtin_amdgcn_s_waitcnt(0);
        unsigned nloc = b.st[0], nx = b.st[1];
        if (nloc == 0u) { xcd_barrier_complete(bar, b.x, nloc, nx); b.st[0] = nloc; b.st[1] = nx; }
        const unsigned old = xb_add(&bar[XB_XSUB(b.x)], 1u);
        const unsigned gen = old / nloc;
        if (old + 1u == (gen + 1u) * nloc) {
            __builtin_amdgcn_fence(__ATOMIC_RELEASE, "agent");
            asm volatile("s_waitcnt vmcnt(0)" ::: "memory");
            const unsigned og = xb_add(&bar[XB_TOP], 1u);
            const unsigned tg = og / nx;
            if (og + 1u == (tg + 1u) * nx) xb_add(&bar[XB_TOPGEN], 1u);
            else XB_SPIN(xb_ld(&bar[XB_TOPGEN]) == tg, bar);
            __builtin_amdgcn_fence(__ATOMIC_ACQUIRE, "agent");
            xb_add(&bar[XB_XGEN(b.x)], 1u);
            asm volatile("s_waitcnt vmcnt(0)" ::: "memory");
        } else {
            XB_SPIN(xb_ld(&bar[XB_XGEN(b.x)]) == gen, bar);
            __builtin_amdgcn_fence(__ATOMIC_ACQUIRE, "agent");
            asm volatile("s_waitcnt vmcnt(0)" ::: "memory");
        }
    }
    __syncthreads();
}

#define HD __host__ __device__ __forceinline__
#ifndef HD
#define HD __host__ __device__ __forceinline__
#endif
typedef float cf __attribute__((ext_vector_type(2)));
#if defined(__HIP_DEVICE_COMPILE__)
#define FFT_OPAQUE(w) asm volatile("" : "+v"(w.x), "+v"(w.y))
#else
#define FFT_OPAQUE(w)
#endif
HD cf cmk(float x, float y) { cf r; r.x = x; r.y = y; return r; }
HD cf cadd(cf a, cf b) { return cmk(a.x + b.x, a.y + b.y); }
HD cf csub(cf a, cf b) { return cmk(a.x - b.x, a.y - b.y); }
HD cf cmul(cf a, cf b) { return cmk(a.x * b.x - a.y * b.y, a.x * b.y + a.y * b.x); }
HD cf cconj(cf a) { return cmk(a.x, -a.y); }
template <bool INV> HD cf mul_mi(cf a) { return INV ? cmk(-a.y, a.x) : cmk(a.y, -a.x); }

template <bool INV> HD void dft4(cf& a, cf& b, cf& c, cf& d) {
    const cf s0 = cadd(a, c), s1 = csub(a, c), s2 = cadd(b, d), s3 = mul_mi<INV>(csub(b, d));
    a = cadd(s0, s2); c = csub(s0, s2); b = cadd(s1, s3); d = csub(s1, s3);
}
template <bool INV> HD void dft16(cf (&x)[16]) {
    const float C1 = 0.92387953251128674f, S1 = 0.38268343236508977f, R2 = 0.70710678118654752f;
#pragma unroll
    for (int na = 0; na < 4; ++na) dft4<INV>(x[na], x[na + 4], x[na + 8], x[na + 12]);
#define TW16(idx, cr, ci) x[idx] = cmul(x[idx], cmk(cr, INV ? -(ci) : (ci)))
    TW16(1 + 4 * 1, C1, -S1);  TW16(1 + 4 * 2, R2, -R2);  TW16(1 + 4 * 3, S1, -C1);
    TW16(2 + 4 * 1, R2, -R2);  TW16(2 + 4 * 2, 0.f, -1.f); TW16(2 + 4 * 3, -R2, -R2);
    TW16(3 + 4 * 1, S1, -C1);  TW16(3 + 4 * 2, -R2, -R2); TW16(3 + 4 * 3, -C1, S1);
#undef TW16
    cf y[16];
#pragma unroll
    for (int kb = 0; kb < 4; ++kb) {
        cf a = x[0 + 4 * kb], b = x[1 + 4 * kb], c = x[2 + 4 * kb], d = x[3 + 4 * kb];
        dft4<INV>(a, b, c, d);
        y[kb + 0] = a; y[kb + 4] = b; y[kb + 8] = c; y[kb + 12] = d;
    }
#pragma unroll
    for (int i = 0; i < 16; ++i) x[i] = y[i];
}
HD void tw_chain(cf (&x)[16], cf base) {
    FFT_OPAQUE(base);
    cf w = base;
#pragma unroll
    for (int j = 1; j < 16; ++j) { x[j] = cmul(x[j], w); if (j < 15) w = cmul(w, base); }
}
HD void tw_chain2(cf (&x)[16], cf start, cf step) {
    FFT_OPAQUE(start); FFT_OPAQUE(step);
    cf w = start;
#pragma unroll
    for (int j = 0; j < 16; ++j) { x[j] = cmul(x[j], w); if (j < 15) w = cmul(w, step); }
}
HD cf cis_pi(float frac) {
    float s, c;
#if defined(__HIP_DEVICE_COMPILE__)
    sincospif(frac, &s, &c);
#else
    s = (float)sin(3.14159265358979323846 * (double)frac); c = (float)cos(3.14159265358979323846 * (double)frac);
#endif
    return cmk(c, s);
}
constexpr int FFT_BUF_ELEMS = 16 * 272;
HD int lay1(int n0, int n1, int k0) { return n0 + 16 * n1 + 272 * k0; }
HD int lay2(int k1, int n0, int k0) { return k1 + 17 * n0 + 272 * k0; }

struct FftTw { cf bA, bB, bIBs, bIBt, wb; };
HD FftTw fft_make_tw(int ht) {
    FftTw T; const int lo = ht & 15, hi = ht >> 4;
    T.bA = cis_pi(-(float)ht * (1.0f / 2048.0f));
    T.bB = cis_pi(-(float)lo * (1.0f / 128.0f));
    T.bIBs = cis_pi((float)(lo * hi) * (1.0f / 2048.0f));
    T.bIBt = cis_pi((float)hi * (1.0f / 128.0f));
    T.wb = cis_pi(-(float)ht * (1.0f / 4096.0f));
    return T;
}
template <class BUF> HD void fft_fA(cf (&x)[16], int ht, BUF buf, const FftTw& T) {
    dft16<false>(x);
    tw_chain(x, T.bA);
    const int n0 = ht & 15, n1 = ht >> 4;
#pragma unroll
    for (int k0 = 0; k0 < 16; ++k0) buf[lay1(n0, n1, k0)] = x[k0];
}
template <class BUF> HD void fft_fB(cf (&x)[16], int ht, BUF bufin, BUF bufout, const FftTw& T) {
    const int n0 = ht & 15, k0 = ht >> 4;
#pragma unroll
    for (int n1 = 0; n1 < 16; ++n1) x[n1] = bufin[lay1(n0, n1, k0)];
    dft16<false>(x);
    tw_chain(x, T.bB);
#pragma unroll
    for (int k1 = 0; k1 < 16; ++k1) bufout[lay2(k1, n0, k0)] = x[k1];
}
template <class BUF> HD void fft_fC(cf (&x)[16], int ht, BUF bufin) {
    const int k1 = ht & 15, k0 = ht >> 4;
#pragma unroll
    for (int n0 = 0; n0 < 16; ++n0) x[n0] = bufin[lay2(k1, n0, k0)];
    dft16<false>(x);
}
template <class BUF> HD void fft_iA(cf (&x)[16], int ht, BUF bufout, const FftTw& T) {
    const int k1 = ht & 15, k0 = ht >> 4;
    dft16<true>(x);
    tw_chain(x, cconj(T.bB));
#pragma unroll
    for (int n0 = 0; n0 < 16; ++n0) bufout[lay2(k1, n0, k0)] = x[n0];
}
template <class BUF> HD void fft_iB(cf (&x)[16], int ht, BUF bufin, BUF bufout, const FftTw& T) {
    const int n0 = ht & 15, k0 = ht >> 4;
#pragma unroll
    for (int k1 = 0; k1 < 16; ++k1) x[k1] = bufin[lay2(k1, n0, k0)];
    dft16<true>(x);
    tw_chain2(x, T.bIBs, T.bIBt);
#pragma unroll
    for (int n1 = 0; n1 < 16; ++n1) bufout[lay1(n0, n1, k0)] = x[n1];
}
template <class BUF> HD void fft_iC(cf (&x)[16], int ht, BUF bufin) {
    const int n0 = ht & 15, n1 = ht >> 4;
#pragma unroll
    for (int k0 = 0; k0 < 16; ++k0) x[k0] = bufin[lay1(n0, n1, k0)];
    dft16<true>(x);
}

constexpr int NWAVES = 8;
#ifndef MK_N_LAUNCHES
#define MK_N_LAUNCHES 1
#endif
constexpr int N_PHASES = 10;
constexpr int NB = 8, SEQ = 4096, DM = 1024, MTOK = NB * SEQ, CTXL = 256, MCTX = NB * CTXL;
constexpr int DIN = 7168, DFF = 2816, NFF = 5632, NMOD = 6144;
constexpr float RMS_EPS = 1e-6f;
constexpr float LOG2E = 1.4426950408889634f;

constexpr size_t MiB = 1u << 20;
constexpr size_t WS_CTL = 0, CTL_ZERO_BYTES = 64 * 1024;
constexpr size_t WS_MOD = 1 * MiB;
constexpr size_t WS_BIAS2P = 1 * MiB + 256 * 1024;
constexpr size_t WS_BINP = 1 * MiB + 512 * 1024;
constexpr size_t WS_SS = 2 * MiB;
constexpr size_t WS_SS2 = 4 * MiB;
constexpr size_t WS_HDN = 6 * MiB;
constexpr size_t WS_WA_T = 8 * MiB, WS_WB_T = 10 * MiB, WS_WOUT_T = 12 * MiB;
constexpr size_t WS_WFFI_T = 14 * MiB;
constexpr size_t WS_WFFO_T = 25 * MiB;
constexpr size_t WS_WIN_T = 31 * MiB;
constexpr size_t WS_XC = 45 * MiB;
constexpr size_t WS_RXC = 49 * MiB;
constexpr size_t WS_SCR = 53 * MiB;
constexpr size_t SCR_PER_BLOCK = 256 * 1024;
constexpr size_t WS_R1 = 117 * MiB;
constexpr size_t WS_R2 = 181 * MiB;
constexpr size_t WS_R3 = 245 * MiB;
constexpr size_t WS_R5 = 309 * MiB;
constexpr size_t WS_END = 501 * MiB;
constexpr int CW_BAR = 1024;

constexpr int LDS_BYTES = 147456;
constexpr int SMALL_OFF = 139264;
constexpr int MISC_OFF = 147200;

struct Frame {
    LAS unsigned char* lds;
    int tid, lane, wave, G, vcu;
    const float* const* in;
    float* out; unsigned char* ws;
};

__device__ __forceinline__ float bf2f(unsigned h) { return __uint_as_float(h << 16); }
__device__ __forceinline__ float sigmoidf_fast(float x) { return __builtin_amdgcn_rcpf(1.0f + __builtin_amdgcn_exp2f(-x * LOG2E)); }
__device__ __forceinline__ float siluf_fast(float x) { return x * sigmoidf_fast(x); }
__device__ __forceinline__ float gelu_tanh_fast(float x) { const float u = 1.5957691216057308f * (x + 0.044715f * x * x * x); return x * sigmoidf_fast(u); }
__device__ __forceinline__ float wave_sum(float v) {
#pragma unroll
    for (int o = 1; o < 64; o <<= 1) v += __shfl_xor(v, o);
    return v;
}
__device__ __forceinline__ int src_col_win(int n) { return n < 2048 ? n : (n < 4096 ? n + 3072 : n - 2048); }
__device__ __forceinline__ int src_col_ffi(int n) { const int g = n >> 5, i = n & 31; return i < 16 ? 16 * g + i : DFF + 16 * g + (i - 16); }
__device__ __forceinline__ int new_col_ffi(int n) { const int j = n < DFF ? n : n - DFF; return 32 * (j >> 4) + (n < DFF ? 0 : 16) + (j & 15); }

template <int MAP>
__device__ __forceinline__ void p0_transpose_item(const float* W, int K, int N, bf16* WT, LAS float* scr, int item, int nblk, int lane) {
    const int kb = item / nblk, nb = item % nblk, k0 = 64 * kb, n0 = 32 * nb;
    const int nn = n0 + (lane & 31);
    const int sc = MAP == 1 ? src_col_win(nn) : (MAP == 2 ? src_col_ffi(nn) : nn);
#pragma unroll 8
    for (int i = 0; i < 32; ++i) { const int kk = 2 * i + (lane >> 5); scr[kk * 33 + (lane & 31)] = W[(size_t)(k0 + kk) * N + sc]; }
    LDS_WAIT(); asm volatile("" ::: "memory");
    const int c = lane & 7;
#pragma unroll
    for (int j = 0; j < 4; ++j) { const int n = (lane >> 3) + 8 * j; const LAS float* s = scr + (8 * c) * 33 + n;
        v4u o; o.x = pk2(s[0 * 33], s[1 * 33]); o.y = pk2(s[2 * 33], s[3 * 33]); o.z = pk2(s[4 * 33], s[5 * 33]); o.w = pk2(s[6 * 33], s[7 * 33]);
        *(GAS v4u*)(WT + (size_t)(n0 + n) * K + k0 + 8 * c) = o; }
    LDS_WAIT(); asm volatile("" ::: "memory");
}
template <class OutFn>
__device__ __forceinline__ void gemv64(Frame& F, const LAS float* S, const float* W, int N, int col0, LAS float* red, OutFn out) {
    const int col = col0 + F.lane; const int k0 = F.wave * 128;
    float acc[9];
#pragma unroll
    for (int r = 0; r < 9; ++r) acc[r] = 0.f;
    const GAS float* wp = (const GAS float*)W + (size_t)k0 * N + col;
#pragma unroll 8
    for (int k = 0; k < 128; ++k) { const float w = wp[(size_t)k * N];
#pragma unroll
        for (int r = 0; r < 9; ++r) acc[r] += S[r * 1024 + k0 + k] * w; }
#pragma unroll
    for (int r = 0; r < 9; ++r) red[(F.wave * 9 + r) * 64 + F.lane] = acc[r];
    __syncthreads();
    for (int idx = F.tid; idx < 576; idx += 512) { const int r = idx >> 6, c = idx & 63; float s = 0.f;
#pragma unroll
        for (int w = 0; w < 8; ++w) s += red[(w * 9 + r) * 64 + c];
        out(r, col0 + c, s); }
    __syncthreads();
}
__device__ __forceinline__ void p0_hdn_row(Frame& F, int t) {
    const float* w1 = F.in[19]; const float* b1 = F.in[20]; const float* w2 = F.in[21]; const float* b2 = F.in[22];
    const float* w3 = F.in[23]; const float* b3 = F.in[24]; const float* fq_ = F.in[25];
    const int lane = F.lane; const float freq = fq_[lane];
    float zv = 0.f;
    if (lane == 0) zv = (float)t * (1.0f / 4095.0f);
    else if (lane < 33) { const int j = (lane - 1) & 15; const double fj = 1e-4 + (double)j * ((15.0 - 1e-4) / 15.0);
        double ph = fj * (double)t * (1.0 / 4096.0); ph -= floor(ph); float s, c; sincospif(2.0f * (float)ph, &s, &c); zv = lane < 17 ? c : -s; }
    float a = b1[lane];
#pragma unroll
    for (int i = 0; i < 33; ++i) a += __int_as_float(__builtin_amdgcn_readlane(__float_as_int(zv), i)) * w1[i * 64 + lane];
    float h = __sinf(freq * a);
    a = b2[lane];
#pragma unroll
    for (int i = 0; i < 64; ++i) a += __int_as_float(__builtin_amdgcn_readlane(__float_as_int(h), i)) * w2[i * 64 + lane];
    h = __sinf(freq * a);
    a = b3[lane];
#pragma unroll
    for (int i = 0; i < 64; ++i) a += __int_as_float(__builtin_amdgcn_readlane(__float_as_int(h), i)) * w3[i * 64 + lane];
    h = __sinf(freq * a);
    ((bf16*)(F.ws + WS_HDN))[t * 64 + lane] = (bf16)f2bf(h);
}
__device__ __forceinline__ void p0_prologue(Frame& F) {
    const int gw = F.vcu * NWAVES + F.wave, NGW = F.G * NWAVES;
    {
        LAS float* S = (LAS float*)F.lds; LAS float* red = (LAS float*)(F.lds + 36864);
        if ((int)blockIdx.x < NMOD / 64) {
            const float* c = F.in[1]; const float* cc = F.in[3];
            for (int idx = F.tid; idx < 9 * 1024; idx += 512) { const float v = idx < 8192 ? c[idx] : cc[idx - 8192]; S[idx] = siluf_fast(v); }
            __syncthreads();
            float* MOD = (float*)(F.ws + WS_MOD); const float* bm = F.in[5];
            for (int it = blockIdx.x; it < NMOD / 64; it += F.G)
                gemv64(F, S, F.in[4], NMOD, it * 64, red, [&](int r, int n, float s) { MOD[r * NMOD + n] = s + bm[n]; });
        }
        __syncthreads();
    }
    {
        LAS float* scr = (LAS float*)(F.lds + 57344 + F.wave * 8704);
        constexpr int I_IN = 16 * (DIN / 32), I_SQ = 16 * 32, I_FI = 16 * (NFF / 32), I_FO = (DFF / 64) * 32;
        constexpr int NITEMS = I_IN + 3 * I_SQ + I_FI + I_FO;
        for (int it = gw; it < NITEMS; it += NGW) {
            int r = it;
            if (r < I_IN) { p0_transpose_item<1>(F.in[8], DM, DIN, (bf16*)(F.ws + WS_WIN_T), scr, r, DIN / 32, F.lane); continue; } r -= I_IN;
            if (r < I_SQ) { p0_transpose_item<0>(F.in[28], DM, DM, (bf16*)(F.ws + WS_WA_T), scr, r, 32, F.lane); continue; } r -= I_SQ;
            if (r < I_SQ) { p0_transpose_item<0>(F.in[29], DM, DM, (bf16*)(F.ws + WS_WB_T), scr, r, 32, F.lane); continue; } r -= I_SQ;
            if (r < I_SQ) { p0_transpose_item<0>(F.in[30], DM, DM, (bf16*)(F.ws + WS_WOUT_T), scr, r, 32, F.lane); continue; } r -= I_SQ;
            if (r < I_FI) { p0_transpose_item<2>(F.in[31], DM, NFF, (bf16*)(F.ws + WS_WFFI_T), scr, r, NFF / 32, F.lane); continue; } r -= I_FI;
            p0_transpose_item<0>(F.in[32], DFF, DM, (bf16*)(F.ws + WS_WFFO_T), scr, r, 32, F.lane);
        }
    }
    for (int t = gw; t < SEQ; t += NGW) p0_hdn_row(F, t);
    { float* BINP = (float*)(F.ws + WS_BINP); const float* bin = F.in[9];
      for (int n = blockIdx.x * 512 + F.tid; n < DIN; n += F.G * 512) BINP[n] = bin[src_col_win(n)]; }
}
__device__ __forceinline__ void p1_norm_row(Frame& F, const float* xrow, bf16* orow, const float* g, const float* sh, const float* sc) {
    const GAS f32x4* xr = (const GAS f32x4*)xrow + F.lane;
    f32x4 v[4]; float s = 0.f;
#pragma unroll
    for (int j = 0; j < 4; ++j) { v[j] = xr[64 * j]; s += (v[j].x * v[j].x + v[j].y * v[j].y) + (v[j].z * v[j].z + v[j].w * v[j].w); }
    const float rstd = 1.0f / sqrtf(wave_sum(s) * (1.0f / DM) + RMS_EPS);
    GAS unsigned long long* o8 = (GAS unsigned long long*)orow + F.lane;
#pragma unroll
    for (int j = 0; j < 4; ++j) {
        const f32x4 gg = ((const GAS f32x4*)g)[64 * j + F.lane], ss = ((const GAS f32x4*)sh)[64 * j + F.lane], cc = ((const GAS f32x4*)sc)[64 * j + F.lane];
        const float a = v[j].x * rstd * gg.x * (1.f + cc.x) + ss.x, b = v[j].y * rstd * gg.y * (1.f + cc.y) + ss.y;
        const float c = v[j].z * rstd * gg.z * (1.f + cc.z) + ss.z, d = v[j].w * rstd * gg.w * (1.f + cc.w) + ss.w;
        o8[64 * j] = (unsigned long long)pk2(a, b) | ((unsigned long long)pk2(c, d) << 32);
    }
}
__device__ __forceinline__ void p1_phase(Frame& F) {
    const int gw = F.vcu * NWAVES + F.wave, NGW = F.G * NWAVES;
    const float* MOD = (const float*)(F.ws + WS_MOD);
    {
        LAS float* S = (LAS float*)F.lds; LAS float* red = (LAS float*)(F.lds + 36864);
        if ((int)blockIdx.x < NFF / 64) {
            for (int idx = F.tid; idx < 9 * 1024; idx += 512) { const int r = idx >> 10, k = idx & 1023; S[idx] = r < 8 ? MOD[r * NMOD + 3072 + k] : 0.f; }
            __syncthreads();
            float* B2 = (float*)(F.ws + WS_BIAS2P);
            for (int it = blockIdx.x; it < NFF / 64; it += F.G)
                gemv64(F, S, F.in[31], NFF, it * 64, red, [&](int r, int n, float s) { if (r < 8) B2[r * NFF + new_col_ffi(n)] = s; });
        }
        __syncthreads();
    }
    const float* g1n = F.in[6];
    bf16* XN = (bf16*)(F.ws + WS_R1); bf16* XC = (bf16*)(F.ws + WS_XC);
    for (int m = gw; m < MTOK + MCTX; m += NGW) {
        if (m < MTOK) { const int b = m >> 12; p1_norm_row(F, F.in[0] + (size_t)m * DM, XN + (size_t)m * DM, g1n, MOD + b * NMOD, MOD + b * NMOD + 1024); }
        else { const int mc = m - MTOK; p1_norm_row(F, F.in[2] + (size_t)mc * DM, XC + (size_t)mc * DM, g1n, MOD + 8 * NMOD, MOD + 8 * NMOD + 1024); }
    }
}
using pg8::f32x4; using pg8::u32x4; using pg8::Unit; using pg8::cvt_pk_bf16;
typedef unsigned u32x2v __attribute__((ext_vector_type(2)));

struct EpiIn {
    static constexpr bool PERM = true, AFTER_DRAIN = false;
    bf16* RX; bf16* RG; bf16* BG; const float* binp;
    __device__ __forceinline__ void operator()(const f32x4 (&acc)[2][2][4][2], const Unit& u, int wr, int wc, int fr, int fq) const {
        const int row0 = u.pm * 256 + wr * 64 + fr; const int colt = u.pn * 256; const int region = u.pn >> 2;
        const int col0 = colt + wc * 32 + 8 * fq;
        bf16* base; int ld, c0;
        if (region == 0) { base = RX; ld = DM; c0 = col0; } else if (region == 1) { base = RG; ld = DM; c0 = col0 - 1024; } else { base = BG; ld = 2048; c0 = col0 - 2048; }
        f32x4 bv[2][2];
#pragma unroll
        for (int bj = 0; bj < 2; ++bj)
#pragma unroll
            for (int n = 0; n < 2; ++n) bv[bj][n] = *(const f32x4*)(binp + col0 + bj * 128 + 4 * n);
#pragma unroll
        for (int ai = 0; ai < 2; ++ai)
#pragma unroll
            for (int m = 0; m < 4; ++m) { bf16* rowp = base + (size_t)(row0 + ai * 128 + m * 16) * ld + c0;
#pragma unroll
                for (int bj = 0; bj < 2; ++bj) { f32x4 v0 = acc[ai][bj][m][0] + bv[bj][0], v1 = acc[ai][bj][m][1] + bv[bj][1];
                    if (region == 1) {
#pragma unroll
                        for (int e = 0; e < 4; ++e) { v0[e] = gelu_tanh_fast(v0[e]); v1[e] = gelu_tanh_fast(v1[e]); }
                    } else if (region >= 2) {
#pragma unroll
                        for (int e = 0; e < 4; ++e) { v0[e] = sigmoidf_fast(v0[e]); v1[e] = sigmoidf_fast(v1[e]); }
                    }
                    u32x4 w; w.x = cvt_pk_bf16(v0[0], v0[1]); w.y = cvt_pk_bf16(v0[2], v0[3]); w.z = cvt_pk_bf16(v1[0], v1[1]); w.w = cvt_pk_bf16(v1[2], v1[3]);
                    *(u32x4*)(rowp + bj * 128) = w; } }
    }
};
struct EpiPhy {
    static constexpr bool PERM = true, AFTER_DRAIN = false;
    bf16* O; const float* brow;
    __device__ __forceinline__ void operator()(const f32x4 (&acc)[2][2][4][2], const Unit& u, int wr, int wc, int fr, int fq) const {
        const int row0 = u.pm * 256 + wr * 64 + fr; const int col0 = u.pn * 256 + wc * 32 + 8 * fq;
#pragma unroll
        for (int ai = 0; ai < 2; ++ai)
#pragma unroll
            for (int m = 0; m < 4; ++m) { const int row = row0 + ai * 128 + m * 16; const float b = brow[row]; bf16* rowp = O + (size_t)row * MTOK + col0;
#pragma unroll
                for (int bj = 0; bj < 2; ++bj) { const f32x4 v0 = acc[ai][bj][m][0] + b, v1 = acc[ai][bj][m][1] + b;
                    u32x4 w; w.x = cvt_pk_bf16(v0[0], v0[1]); w.y = cvt_pk_bf16(v0[2], v0[3]); w.z = cvt_pk_bf16(v1[0], v1[1]); w.w = cvt_pk_bf16(v1[2], v1[3]);
                    *(u32x4*)(rowp + bj * 128) = w; } }
    }
};
__device__ __forceinline__ void unpack8(const u32x4 w, float (&f)[8]) {
    f[0] = bf2f(w.x & 0xffffu); f[1] = bf2f(w.x >> 16); f[2] = bf2f(w.y & 0xffffu); f[3] = bf2f(w.y >> 16);
    f[4] = bf2f(w.z & 0xffffu); f[5] = bf2f(w.z >> 16); f[6] = bf2f(w.w & 0xffffu); f[7] = bf2f(w.w >> 16);
}
struct EpiDual {
    static constexpr bool PERM = true, AFTER_DRAIN = false;
    bf16* T1; const bf16* BG;
    static constexpr size_t MG_DELTA = (WS_R5 + 64 * MiB - WS_R1) / 2;
    __device__ __forceinline__ void operator()(const f32x4 (&acc)[2][2][4][2], const Unit& u, int wr, int wc, int fr, int fq) const {
        const int row0 = u.pm * 256 + wr * 64 + fr; const int col0 = u.pn * 256 + wc * 32 + 8 * fq;
#pragma unroll
        for (int ai = 0; ai < 2; ++ai)
#pragma unroll
            for (int m = 0; m < 4; ++m) { const size_t row = (size_t)(row0 + ai * 128 + m * 16);
#pragma unroll
                for (int bj = 0; bj < 2; ++bj) { const int col = col0 + bj * 128;
                    const u32x4 gw = *(const u32x4*)(BG + row * 2048 + (u.sel ? 1024 : 0) + col);
                    float g[8]; unpack8(gw, g);
                    float v[8];
#pragma unroll
                    for (int e = 0; e < 4; ++e) { v[e] = acc[ai][bj][m][0][e] * g[e]; v[4 + e] = acc[ai][bj][m][1][e] * g[4 + e]; }
                    if (u.sel) { const u32x4 tw = *(const u32x4*)(T1 + row * DM + col); float t[8]; unpack8(tw, t);
#pragma unroll
                        for (int e = 0; e < 8; ++e) v[e] += t[e]; }
                    u32x4 w; w.x = cvt_pk_bf16(v[0], v[1]); w.y = cvt_pk_bf16(v[2], v[3]); w.z = cvt_pk_bf16(v[4], v[5]); w.w = cvt_pk_bf16(v[6], v[7]);
                    *(u32x4*)(T1 + (u.sel ? MG_DELTA : (size_t)0) + row * DM + col) = w; } }
    }
};
struct EpiOut {
    static constexpr bool PERM = true, AFTER_DRAIN = false;
    const float* x; float* X1; bf16* A2; float* SS; const float* MOD; const float* g2n;
    __device__ __forceinline__ void operator()(const f32x4 (&acc)[2][2][4][2], const Unit& u, int wr, int wc, int fr, int fq) const {
        const int row0 = u.pm * 256 + wr * 64 + fr; const int col0 = u.pn * 256 + wc * 32 + 8 * fq;
        const int b = (u.pm * 256) >> 12; const float* mod = MOD + b * NMOD;
        f32x4 g1v[2][2], G2v[2][2];
#pragma unroll
        for (int bj = 0; bj < 2; ++bj)
#pragma unroll
            for (int n = 0; n < 2; ++n) { const int c = col0 + bj * 128 + 4 * n; g1v[bj][n] = *(const f32x4*)(mod + 2048 + c);
                const f32x4 gg = *(const f32x4*)(g2n + c), sc = *(const f32x4*)(mod + 4096 + c); G2v[bj][n] = gg * (sc + 1.0f); }
#pragma unroll
        for (int ai = 0; ai < 2; ++ai)
#pragma unroll
            for (int m = 0; m < 4; ++m) { const size_t row = (size_t)(row0 + ai * 128 + m * 16); float ss = 0.f;
#pragma unroll
                for (int bj = 0; bj < 2; ++bj) { const size_t off = row * DM + col0 + bj * 128;
                    const f32x4 xa = *(const f32x4*)(x + off), xb = *(const f32x4*)(x + off + 4);
                    const f32x4 v0 = xa + g1v[bj][0] * acc[ai][bj][m][0], v1 = xb + g1v[bj][1] * acc[ai][bj][m][1];
                    *(f32x4*)(X1 + off) = v0; *(f32x4*)(X1 + off + 4) = v1;
                    ss += (v0[0] * v0[0] + v0[1] * v0[1]) + (v0[2] * v0[2] + v0[3] * v0[3]) + (v1[0] * v1[0] + v1[1] * v1[1]) + (v1[2] * v1[2] + v1[3] * v1[3]);
                    const f32x4 a0 = v0 * G2v[bj][0], a1 = v1 * G2v[bj][1];
                    u32x4 w; w.x = cvt_pk_bf16(a0[0], a0[1]); w.y = cvt_pk_bf16(a0[2], a0[3]); w.z = cvt_pk_bf16(a1[0], a1[1]); w.w = cvt_pk_bf16(a1[2], a1[3]);
                    *(u32x4*)(A2 + off) = w; }
                ss += __shfl_xor(ss, 16); ss += __shfl_xor(ss, 32);
                if (fq == 0) SS[row * 16 + u.pn * 4 + wc] = ss; }
    }
};
struct EpiFfn {
    static constexpr bool PERM = false, AFTER_DRAIN = false;
    const float* SS; const float* B2; bf16* ACT;
    __device__ __forceinline__ void operator()(const f32x4 (&acc)[2][2][4][2], const Unit& u, int wr, int wc, int fr, int fq) const {
        const int row0 = u.pm * 256 + wr * 64 + fr; const int col0 = u.pn * 256 + wc * 32 + 4 * fq;
        const int b = (u.pm * 256) >> 12; const float* b2 = B2 + b * NFF;
        f32x4 bv[2][2];
#pragma unroll
        for (int bj = 0; bj < 2; ++bj)
#pragma unroll
            for (int n = 0; n < 2; ++n) bv[bj][n] = *(const f32x4*)(b2 + col0 + bj * 128 + n * 16);
#pragma unroll
        for (int ai = 0; ai < 2; ++ai)
#pragma unroll
            for (int m = 0; m < 4; ++m) { const size_t row = (size_t)(row0 + ai * 128 + m * 16);
                const f32x4* sp = (const f32x4*)(SS + row * 16); const f32x4 s0 = sp[0], s1 = sp[1], s2 = sp[2], s3 = sp[3];
                const float tot = ((s0[0] + s0[1]) + (s0[2] + s0[3])) + ((s1[0] + s1[1]) + (s1[2] + s1[3])) + ((s2[0] + s2[1]) + (s2[2] + s2[3])) + ((s3[0] + s3[1]) + (s3[2] + s3[3]));
                const float rstd = 1.0f / sqrtf(tot * (1.0f / DM) + RMS_EPS);
#pragma unroll
                for (int bj = 0; bj < 2; ++bj) { const f32x4 g = acc[ai][bj][m][0] * rstd + bv[bj][0], uu = acc[ai][bj][m][1] * rstd + bv[bj][1];
                    const int grp = 8 * u.pn + 4 * bj + wc;
                    u32x2v w; w.x = cvt_pk_bf16(siluf_fast(g[0]) * uu[0], siluf_fast(g[1]) * uu[1]); w.y = cvt_pk_bf16(siluf_fast(g[2]) * uu[2], siluf_fast(g[3]) * uu[3]);
                    *(u32x2v*)(ACT + row * DFF + 16 * grp + 4 * fq) = w; } }
    }
};
struct EpiDown {
    static constexpr bool PERM = false, AFTER_DRAIN = false;
    float* X; float* SS2; const float* MOD;
    __device__ __forceinline__ void operator()(const f32x4 (&acc)[2][2][4][2], const Unit& u, int wr, int wc, int fr, int fq) const {
        const int row0 = u.pm * 256 + wr * 64 + fr; const int col0 = u.pn * 256 + wc * 32 + 4 * fq;
        const int b = (u.pm * 256) >> 12; const float* mod = MOD + b * NMOD;
        f32x4 g2v[2][2];
#pragma unroll
        for (int bj = 0; bj < 2; ++bj)
#pragma unroll
            for (int n = 0; n < 2; ++n) g2v[bj][n] = *(const f32x4*)(mod + 5120 + col0 + bj * 128 + n * 16);
#pragma unroll
        for (int ai = 0; ai < 2; ++ai)
#pragma unroll
            for (int m = 0; m < 4; ++m) { const size_t row = (size_t)(row0 + ai * 128 + m * 16); float ss = 0.f;
#pragma unroll
                for (int bj = 0; bj < 2; ++bj)
#pragma unroll
                    for (int n = 0; n < 2; ++n) { float* p = X + row * DM + col0 + bj * 128 + n * 16;
                        const f32x4 v = *(const f32x4*)p + g2v[bj][n] * acc[ai][bj][m][n]; *(f32x4*)p = v;
                        ss += (v[0] * v[0] + v[1] * v[1]) + (v[2] * v[2] + v[3] * v[3]); }
                ss += __shfl_xor(ss, 16); ss += __shfl_xor(ss, 32);
                if (fq == 0) SS2[row * 16 + u.pn * 4 + wc] = ss; }
    }
};
struct DualOrder {
    pg8::StaticOrder so;
    __device__ __forceinline__ bool next(int i, Unit& u) const { const bool ok = so.next(i >> 1, u); u.sel = i & 1; return ok; }
    __device__ __forceinline__ void a_ready(const Unit&) const {}
    __device__ __forceinline__ void done(const Unit&) const {}
};
typedef short bf16x8s __attribute__((ext_vector_type(8)));
__device__ __forceinline__ f32x4 mfma16(bf16x8s a, bf16x8s b, f32x4 c) { return __builtin_amdgcn_mfma_f32_16x16x32_bf16(a, b, c, 0, 0, 0); }

template <bool BWD, bool CTX>
__device__ __forceinline__ void rnn_pass(Frame& F, int b, int h, int q, float (&cS)[2]) {
    int lane = F.lane;
    asm volatile("" : "+v"(lane));
    const int fr = lane & 15, fq = lane >> 4, w = F.wave;
    constexpr int dir = BWD ? 1 : 0;
    const LAS float* cw = (const LAS float*)F.lds;
    LAS float* tab = (LAS float*)(F.lds + 2048);
    const bf16* RXp = CTX ? (const bf16*)(F.ws + WS_RXC) : (const bf16*)(F.ws + WS_R2);
    bf16* HF = (bf16*)(F.ws + WS_R1); bf16* RG = (bf16*)(F.ws + WS_R3);
    constexpr int seqlen = CTX ? CTXL : SEQ;
    bf16x8s Wr[2][2], Wi[2][2], Id[2];
    {
        const float* wa = F.in[12] + (size_t)(dir * 16 + h) * 4096; const float* wx = F.in[14] + (size_t)(dir * 16 + h) * 4096;
#pragma unroll
        for (int n = 0; n < 2; ++n) {
            const int j = q * 32 + 16 * n + fr;
#pragma unroll
            for (int ks = 0; ks < 2; ++ks)
#pragma unroll
                for (int jj = 0; jj < 8; ++jj) { const int i = 8 * fq + jj + 32 * ks; Wr[n][ks][jj] = (short)f2bf(wa[i * 64 + j]); Wi[n][ks][jj] = (short)f2bf(wx[i * 64 + j]); }
#pragma unroll
            for (int jj = 0; jj < 8; ++jj) Id[n][jj] = (8 * fq + jj == 16 * n + fr) ? (short)0x3F80 : (short)0;
        }
    }
    float ba_[2], bx_[2], nsp[2];
#pragma unroll
    for (int n = 0; n < 2; ++n) { const int c = h * 64 + q * 32 + 16 * n + fr;
        ba_[n] = F.in[13][dir * 1024 + c]; bx_[n] = F.in[15][dir * 1024 + c];
        const float lam = F.in[16][dir * 1024 + c]; nsp[n] = -8.0f * log1pf(expf(-lam)) * LOG2E; }
    __syncthreads();
    constexpr int nsuper = CTX ? 1 : 8;
    for (int si = 0; si < nsuper; ++si) {
        const int s = BWD ? nsuper - 1 - si : si;
        const int t0 = s * 512 + w * 64;
        const bool active = CTX ? (w < 4) : true;
        float P[4][2][4], Hl[4][2][4], RA[4][2], RH[4][2];
        if (active) {
#pragma unroll
            for (int m = 0; m < 4; ++m) {
                bf16x8s Au[2];
                {
                    const LAS float* cwp = cw; asm volatile("" : "+v"(cwp));
#pragma unroll
                    for (int ks = 0; ks < 2; ++ks) {
                        const int tt = t0 + 16 * m + fr, ci = 32 * ks + 8 * fq;
                        float u8[8];
                        { const f32x4 b0 = *(const LAS f32x4*)(cwp + 256 + ci), b1 = *(const LAS f32x4*)(cwp + 256 + ci + 4);
                          u8[0] = b0[0]; u8[1] = b0[1]; u8[2] = b0[2]; u8[3] = b0[3]; u8[4] = b1[0]; u8[5] = b1[1]; u8[6] = b1[2]; u8[7] = b1[3]; }
#pragma unroll
                        for (int k = 0; k < 4; ++k) {
                            const int off = k - 2;
                            const bool valid = CTX ? (tt + off >= 0 && tt + off < CTXL) : (16 * m + fr + off >= 0 && 16 * m + fr + off < 64);
                            const int tl = valid ? tt + off : tt;
                            const u32x4 rv = *(const u32x4*)(RXp + ((size_t)(b * seqlen + tl)) * DM + h * 64 + ci);
                            float xv[8]; unpack8(rv, xv);
                            f32x4 w0 = *(const LAS f32x4*)(cwp + k * 64 + ci), w1 = *(const LAS f32x4*)(cwp + k * 64 + ci + 4);
                            if (!valid) { w0 = (f32x4){0.f, 0.f, 0.f, 0.f}; w1 = w0; }
                            u8[0] += w0[0] * xv[0]; u8[1] += w0[1] * xv[1]; u8[2] += w0[2] * xv[2]; u8[3] += w0[3] * xv[3];
                            u8[4] += w1[0] * xv[4]; u8[5] += w1[1] * xv[5]; u8[6] += w1[2] * xv[6]; u8[7] += w1[3] * xv[7];
                        }
                        u32x4 pk; pk.x = pk2(u8[0], u8[1]); pk.y = pk2(u8[2], u8[3]); pk.z = pk2(u8[4], u8[5]); pk.w = pk2(u8[6], u8[7]);
                        Au[ks] = __builtin_bit_cast(bf16x8s, pk);
                    }
                }
                const f32x4 z4 = {0.f, 0.f, 0.f, 0.f};
#pragma unroll
                for (int n = 0; n < 2; ++n) {
                    f32x4 aR = mfma16(Au[0], Wr[n][0], z4); aR = mfma16(Au[1], Wr[n][1], aR);
                    f32x4 aI = mfma16(Au[0], Wi[n][0], z4); aI = mfma16(Au[1], Wi[n][1], aI);
                    const f32x4 aU = q ? mfma16(Au[1], Id[n], z4) : mfma16(Au[0], Id[n], z4);
                    float av[4], bv[4];
#pragma unroll
                    for (int e = 0; e < 4; ++e) {
                        const float r = sigmoidf_fast(aR[e] + ba_[n]), ig = sigmoidf_fast(aI[e] + bx_[n]);
                        const float a = __builtin_amdgcn_exp2f(r * nsp[n]);
                        av[e] = a; bv[e] = sqrtf(fmaxf(1.0f - a * a, 0.f)) * ig * aU[e];
                    }
                    if (!BWD) {
                        P[m][n][0] = av[0]; Hl[m][n][0] = bv[0];
#pragma unroll
                        for (int e = 1; e < 4; ++e) { P[m][n][e] = av[e] * P[m][n][e - 1]; Hl[m][n][e] = av[e] * Hl[m][n][e - 1] + bv[e]; }
                        RA[m][n] = P[m][n][3]; RH[m][n] = Hl[m][n][3];
                    } else {
                        P[m][n][3] = av[3]; Hl[m][n][3] = bv[3];
#pragma unroll
                        for (int e = 2; e >= 0; --e) { P[m][n][e] = av[e] * P[m][n][e + 1]; Hl[m][n][e] = av[e] * Hl[m][n][e + 1] + bv[e]; }
                        RA[m][n] = P[m][n][0]; RH[m][n] = Hl[m][n][0];
                    }
                }
            }
        } else {
#pragma unroll
            for (int m = 0; m < 4; ++m)
#pragma unroll
                for (int n = 0; n < 2; ++n) { RA[m][n] = 1.f; RH[m][n] = 0.f;
#pragma unroll
                    for (int e = 0; e < 4; ++e) { P[m][n][e] = 1.f; Hl[m][n][e] = 0.f; } }
        }
        float At[2], Ht[2];
#pragma unroll
        for (int n = 0; n < 2; ++n) {
            float Am[4], Hm[4];
#pragma unroll
            for (int m = 0; m < 4; ++m) {
                float A = RA[m][n], H = RH[m][n];
                const int l1 = BWD ? lane + 16 : lane - 16, l2 = BWD ? lane + 32 : lane - 32;
                { const float A1 = __shfl(A, l1 & 63), H1 = __shfl(H, l1 & 63); const bool ok = BWD ? (fq <= 2) : (fq >= 1); if (ok) { H = A * H1 + H; A = A * A1; } }
                { const float A1 = __shfl(A, l2 & 63), H1 = __shfl(H, l2 & 63); const bool ok = BWD ? (fq <= 1) : (fq >= 2); if (ok) { H = A * H1 + H; A = A * A1; } }
                const int lt = BWD ? fr : fr + 48;
                Am[m] = __shfl(A, lt); Hm[m] = __shfl(H, lt);
                const float Ax = __shfl(A, l1 & 63), Hx = __shfl(H, l1 & 63); const bool okx = BWD ? (fq <= 2) : (fq >= 1);
                RA[m][n] = okx ? Ax : 1.f; RH[m][n] = okx ? Hx : 0.f;
            }
            float cA = 1.f, cH = 0.f;
#pragma unroll
            for (int mi = 0; mi < 4; ++mi) { const int m = BWD ? 3 - mi : mi;
                const float eA = RA[m][n], eH = RH[m][n];
                RA[m][n] = eA * cA; RH[m][n] = eA * cH + eH;
                cH = Am[m] * cH + Hm[m]; cA = Am[m] * cA; }
            At[n] = cA; Ht[n] = cH;
        }
        LAS float* tb = tab + (si & 1) * 512;
        if (fq == 0) {
#pragma unroll
            for (int n = 0; n < 2; ++n) { tb[(w * 32 + 16 * n + fr) * 2 + 0] = At[n]; tb[(w * 32 + 16 * n + fr) * 2 + 1] = Ht[n]; }
        }
        __syncthreads();
        float tin[2];
#pragma unroll
        for (int n = 0; n < 2; ++n) {
            float st = cS[n]; tin[n] = 0.f;
#pragma unroll
            for (int wi = 0; wi < 8; ++wi) { const int ww = BWD ? 7 - wi : wi;
                const float A = tb[(ww * 32 + 16 * n + fr) * 2 + 0], H = tb[(ww * 32 + 16 * n + fr) * 2 + 1];
                if (ww == w) tin[n] = st;
                st = A * st + H; }
            cS[n] = st;
        }
        if (!CTX) {
#pragma unroll
            for (int m = 0; m < 4; ++m)
#pragma unroll
                for (int n = 0; n < 2; ++n) {
                    const float sin_run = RA[m][n] * tin[n] + RH[m][n];
#pragma unroll
                    for (int e = 0; e < 4; ++e) {
                        const float hv = P[m][n][e] * sin_run + Hl[m][n][e];
                        const size_t idx = ((size_t)(b * SEQ + t0 + 16 * m + 4 * fq + e)) * DM + h * 64 + q * 32 + 16 * n + fr;
                        if (!BWD) HF[idx] = (bf16)f2bf(hv);
                        else { const float y = (bf2f(HF[idx]) + hv) * bf2f(RG[idx]); RG[idx] = (bf16)f2bf(y); }
                    }
                }
        }
    }
}
__device__ __forceinline__ void rnn_task(Frame& F, int task) {
    const int b = task >> 5, h = (task >> 1) & 15, q = task & 1;
    __syncthreads();
    { LAS float* cw = (LAS float*)F.lds; const float* w = F.in[10]; const float* cb = F.in[11];
      for (int idx = F.tid; idx < 320; idx += 512) cw[idx] = idx < 256 ? w[(idx >> 6) * DM + h * 64 + (idx & 63)] : cb[h * 64 + (idx - 256)]; }
    __syncthreads();
    float cf_[2] = {0.f, 0.f}, cb_[2] = {0.f, 0.f};
    rnn_pass<false, true>(F, b, h, q, cf_);
    rnn_pass<true, true>(F, b, h, q, cb_);
    rnn_pass<false, false>(F, b, h, q, cf_);
    rnn_pass<true, false>(F, b, h, q, cb_);
}
#define HY_SYNC() __syncthreads()
#define OPAQUE_PTR(p) asm volatile("" : "+v"(p))
__device__ __forceinline__ void hy_taps_pass(Frame& F, int grp, int cp, float* KT) {
    const int lane = F.lane, fr = lane & 15, fq = lane >> 4;
    const float* w4 = F.in[26]; const bf16* HDN = (const bf16*)(F.ws + WS_HDN);
    bf16x8s Bw[2];
    { const int pcx = (fr >> 2) & 1, o = (fr >> 1) & 1, dr = fr & 1; const int wcol = o * 2048 + dr * 1024 + 4 * grp + 2 * cp + pcx;
#pragma unroll
      for (int ks = 0; ks < 2; ++ks)
#pragma unroll
        for (int jj = 0; jj < 8; ++jj) { const int j = 8 * fq + jj + 32 * ks; Bw[ks][jj] = fr < 8 ? (short)f2bf(w4[(size_t)j * 4096 + wcol]) : (short)0; } }
    for (int mb = F.wave; mb < 256; mb += 8) {
        const int t = 16 * mb + fr;
        const bf16x8s a0 = *(const bf16x8s*)(HDN + t * 64 + 8 * fq), a1 = *(const bf16x8s*)(HDN + t * 64 + 32 + 8 * fq);
        f32x4 acc = {0.f, 0.f, 0.f, 0.f};
        acc = mfma16(a0, Bw[0], acc); acc = mfma16(a1, Bw[1], acc);
        if (fr < 8) *(f32x4*)(KT + fr * 4096 + 16 * mb + 4 * fq) = acc;
    }
}
__device__ __forceinline__ void hy_filter_spectra(Frame& F, int d, int pc, const float* KT, cf* KF, LAS cf* buf0, LAS cf* buf1, LAS float* red, const FftTw& T) {
    int hb = F.tid >> 8, ht = F.tid & 255;
    asm volatile("" : "+v"(ht), "+v"(hb));
    const float* kf = KT + (pc * 4 + hb * 2 + 0) * 4096 + ht; const float* kb = KT + (pc * 4 + hb * 2 + 1) * 4096 - ht;
    OPAQUE_PTR(kf); OPAQUE_PTR(kb);
    cf* kfo = KF + (hb * 2) * 16 * 256 + ht; OPAQUE_PTR(kfo);
    const float delta = 3.0701134573253945f + (float)d * (12.280453829301578f / 1023.0f);
    const float dl2 = -delta * LOG2E * (1.0f / 4095.0f);
    cf xe[16], xo[16]; float lsum = 0.f;
    const cf w32 = cmk(0.98078528040323043f, -0.19509032201612825f);
    cf wn = T.wb; FFT_OPAQUE(wn);
#pragma unroll
    for (int n2 = 0; n2 < 16; ++n2) {
        const int n = ht + 256 * n2;
        const float fv = kf[256 * n2] * __builtin_amdgcn_exp2f((float)n * dl2);
        const int nb = n == 0 ? 1 : 4096 - n;
        float bvx = (n2 == 0 ? kb[ht == 0 ? 1 : 4096] : kb[4096 - 256 * n2]) * __builtin_amdgcn_exp2f((float)nb * dl2); if (n == 0) bvx = 0.f;
        lsum += fabsf(fv) + fabsf(bvx);
        xe[n2] = cmk(fv + bvx, 0.f);
        xo[n2] = cmk((fv - bvx) * wn.x, (fv - bvx) * wn.y); wn = cmul(wn, w32);
    }
    lsum = wave_sum(lsum);
    if (F.lane == 0) red[F.wave] = lsum;
    HY_SYNC();
    const float tot = (red[hb * 4 + 0] + red[hb * 4 + 1]) + (red[hb * 4 + 2] + red[hb * 4 + 3]);
    const float scale = 1.0f / (tot * 8192.0f);
#pragma unroll
    for (int i = 0; i < 16; ++i) { xe[i].x *= scale; xe[i].y *= scale; xo[i].x *= scale; xo[i].y *= scale; }
    fft_fA(xe, ht, buf0, T); HY_SYNC(); fft_fB(xe, ht, buf0, buf1, T); HY_SYNC(); fft_fC(xe, ht, buf1);
#pragma unroll
    for (int k2 = 0; k2 < 16; ++k2) kfo[k2 * 256] = xe[k2];
    fft_fA(xo, ht, buf0, T); HY_SYNC(); fft_fB(xo, ht, buf0, buf1, T); HY_SYNC(); fft_fC(xo, ht, buf1);
#pragma unroll
    for (int k2 = 0; k2 < 16; ++k2) kfo[(16 + k2) * 256] = xo[k2];
}
__device__ __forceinline__ float hy_conv3(const bf16* rowp, int t, float w0, float w1, float w2, float bias) {
    const int col = t & 63;
    const float c = bf2f(rowp[t]);
    const float lv = bf2f(rowp[col > 0 ? t - 1 : t]), rv = bf2f(rowp[col < 63 ? t + 1 : t]);
    const float l = col > 0 ? lv : 0.f, r = col < 63 ? rv : 0.f;
    return bias + w0 * l + w1 * c + w2 * r;
}
__device__ __forceinline__ void hy_pair_task(Frame& F, int d, int bp, const cf* KF, LAS cf* buf0, LAS cf* buf1, const FftTw& T) {
    int ht = F.tid & 255;
    asm volatile("" : "+v"(ht));
    bf16* PH = (bf16*)(F.ws + WS_R5);
    const float* cwv = F.in[17]; const float* cbv = F.in[18]; const float* skipv = F.in[27];
    const int b0 = 2 * bp, b1 = 2 * bp + 1;
    cf zr[16];
    {
        const float w0 = cwv[d], w1 = cwv[3072 + d], w2 = cwv[6144 + d], bs = cbv[d];
        const bf16* r0 = PH + (size_t)d * MTOK + b0 * SEQ; const bf16* r1 = PH + (size_t)d * MTOK + b1 * SEQ;
        OPAQUE_PTR(r0); OPAQUE_PTR(r1);
#pragma unroll
        for (int n2 = 0; n2 < 16; ++n2) { const int t = ht + 256 * n2; zr[n2] = cmk(hy_conv3(r0, t, w0, w1, w2, bs), hy_conv3(r1, t, w0, w1, w2, bs)); }
    }
    const cf wb = T.wb;
    const cf w32 = cmk(0.98078528040323043f, -0.19509032201612825f);
#pragma unroll 1
    for (int o = 0; o < 2; ++o) {
        cf acc[16];
        {
            cf x[16];
#pragma unroll
            for (int i = 0; i < 16; ++i) x[i] = zr[i];
            fft_fA(x, ht, buf0, T); HY_SYNC(); fft_fB(x, ht, buf0, buf1, T); HY_SYNC(); fft_fC(x, ht, buf1);
            const cf* kp = KF + ((o * 2 + 0) * 16) * 256 + ht; OPAQUE_PTR(kp);
#pragma unroll
            for (int k2 = 0; k2 < 16; ++k2) x[k2] = cmul(x[k2], kp[k2 * 256]);
            fft_iA(x, ht, buf0, T); HY_SYNC(); fft_iB(x, ht, buf0, buf1, T); HY_SYNC(); fft_iC(x, ht, buf1);
#pragma unroll
            for (int i = 0; i < 16; ++i) acc[i] = x[i];
        }
        {
            cf x[16];
            { cf w = wb; FFT_OPAQUE(w);
#pragma unroll
              for (int i = 0; i < 16; ++i) { x[i] = cmul(zr[i], w); w = cmul(w, w32); } }
            fft_fA(x, ht, buf0, T); HY_SYNC(); fft_fB(x, ht, buf0, buf1, T); HY_SYNC(); fft_fC(x, ht, buf1);
            const cf* kp = KF + ((o * 2 + 1) * 16) * 256 + ht; OPAQUE_PTR(kp);
#pragma unroll
            for (int k2 = 0; k2 < 16; ++k2) x[k2] = cmul(x[k2], kp[k2 * 256]);
            fft_iA(x, ht, buf0, T); HY_SYNC(); fft_iB(x, ht, buf0, buf1, T); HY_SYNC(); fft_iC(x, ht, buf1);
            { cf w = cconj(wb); FFT_OPAQUE(w); const cf w32c = cconj(w32);
#pragma unroll
              for (int i = 0; i < 16; ++i) { acc[i] = cadd(acc[i], cmul(x[i], w)); w = cmul(w, w32c); } }
        }
        {
            const int ch = (1 + o) * 1024 + d;
            const float w0 = cwv[ch], w1 = cwv[3072 + ch], w2 = cwv[6144 + ch], bs = cbv[ch], sk = skipv[o * 1024 + d];
            const bf16* r0 = PH + (size_t)ch * MTOK + b0 * SEQ; const bf16* r1 = PH + (size_t)ch * MTOK + b1 * SEQ;
            OPAQUE_PTR(r0); OPAQUE_PTR(r1);
#pragma unroll
            for (int n2 = 0; n2 < 16; ++n2) { const int t = ht + 256 * n2;
                const float g0 = hy_conv3(r0, t, w0, w1, w2, bs), g1 = hy_conv3(r1, t, w0, w1, w2, bs);
                zr[n2] = cmk(g0 * (acc[n2].x + sk * zr[n2].x), g1 * (acc[n2].y + sk * zr[n2].y)); }
        }
    }
    { bf16* y0 = PH + (size_t)d * MTOK + b0 * SEQ; bf16* y1 = PH + (size_t)d * MTOK + b1 * SEQ;
      OPAQUE_PTR(y0); OPAQUE_PTR(y1);
#pragma unroll
      for (int n2 = 0; n2 < 16; ++n2) { const int t = ht + 256 * n2; y0[t] = (bf16)f2bf(zr[n2].x); y1[t] = (bf16)f2bf(zr[n2].y); } }
}
__device__ __forceinline__ void hy_group(Frame& F, int grp) {
    const int hb = F.tid >> 8;
    const FftTw T = fft_make_tw(F.tid & 255);
    LAS cf* buf0 = (LAS cf*)(F.lds + hb * (2 * FFT_BUF_ELEMS * 8)); LAS cf* buf1 = buf0 + FFT_BUF_ELEMS;
    LAS float* red = (LAS float*)(F.lds + SMALL_OFF);
    float* KT = (float*)(F.ws + WS_SCR + (size_t)blockIdx.x * SCR_PER_BLOCK);
    cf* KF = (cf*)(F.ws + WS_SCR + (size_t)blockIdx.x * SCR_PER_BLOCK + 131072);
    for (int cp = 0; cp < 2; ++cp) {
        HY_SYNC();
        hy_taps_pass(F, grp, cp, KT);
        HY_SYNC();
        for (int pc = 0; pc < 2; ++pc) {
            const int d = 4 * grp + 2 * cp + pc;
            hy_filter_spectra(F, d, pc, KT, KF, buf0, buf1, red, T);
            HY_SYNC();
            for (int it = 0; it < 2; ++it) hy_pair_task(F, d, 2 * it + hb, KF, buf0, buf1, T);
            HY_SYNC();
        }
    }
}
__device__ __forceinline__ void p4_transpose(Frame& F) {
    const int gw = F.vcu * NWAVES + F.wave, NGW = F.G * NWAVES, lane = F.lane;
    const bf16* YT = (const bf16*)(F.ws + WS_R5); bf16* Y = (bf16*)(F.ws + WS_R2);
    LAS bf16* tile = (LAS bf16*)(F.lds + F.wave * 9216);
    for (int item = gw; item < 16 * 512; item += NGW) {
        const int c0 = (item >> 9) * 64, t0 = (item & 511) * 64;
#pragma unroll
        for (int i = 0; i < 8; ++i) { const int row = i * 8 + (lane >> 3), chunk = lane & 7;
            const u32x4 v = *(const u32x4*)(YT + (size_t)(c0 + row) * MTOK + t0 + 8 * chunk);
            const unsigned ww[4] = {v.x, v.y, v.z, v.w};
#pragma unroll
            for (int e = 0; e < 8; ++e) tile[(8 * chunk + e) * 72 + row] = (bf16)((ww[e >> 1] >> (16 * (e & 1))) & 0xffffu); }
        LDS_WAIT(); asm volatile("" ::: "memory");
#pragma unroll
        for (int i = 0; i < 8; ++i) { const int tok = i * 8 + (lane >> 3), chunk = lane & 7;
            const u32x4 v = *(const LAS u32x4*)(tile + tok * 72 + 8 * chunk);
            *(u32x4*)(Y + (size_t)(t0 + tok) * DM + c0 + 8 * chunk) = v; }
        LDS_WAIT(); asm volatile("" ::: "memory");
    }
}
__device__ __forceinline__ void p9_final(Frame& F) {
    const int gw = F.vcu * NWAVES + F.wave, NGW = F.G * NWAVES, lane = F.lane;
    const float* SS2 = (const float*)(F.ws + WS_SS2); const float* fg = F.in[33];
    for (int m = gw; m < MTOK; m += NGW) {
        float s = SS2[(size_t)m * 16 + (lane & 15)];
        s += __shfl_xor(s, 1); s += __shfl_xor(s, 2); s += __shfl_xor(s, 4); s += __shfl_xor(s, 8);
        const float rstd = 1.0f / sqrtf(s * (1.0f / DM) + RMS_EPS);
        GAS f32x4* xr = (GAS f32x4*)(F.out + (size_t)m * DM) + lane;
#pragma unroll
        for (int j = 0; j < 4; ++j) { const f32x4 g = ((const GAS f32x4*)fg)[64 * j + lane]; const f32x4 v = xr[64 * j]; xr[64 * j] = v * rstd * g; }
    }
}
struct Args { const float* in[34]; float* out; unsigned char* ws; int ph_lo, ph_hi; };
__global__ void __launch_bounds__(NWAVES * 64, 2) mk_fwd(Args args) {
    extern __shared__ __attribute__((aligned(16))) unsigned char lds_raw[];
    Frame F;
    F.lds = (LAS unsigned char*)lds_raw;
    F.tid = threadIdx.x; F.lane = F.tid & 63; F.wave = __builtin_amdgcn_readfirstlane(F.tid >> 6);
    F.G = gridDim.x; { const int bx = blockIdx.x; F.vcu = (F.G % 8 == 0) ? (bx % 8) * (F.G / 8) + bx / 8 : bx; }
    F.in = args.in; F.out = args.out; F.ws = args.ws;
    unsigned char* ws = args.ws;
    volatile LAS unsigned* MISC = (volatile LAS unsigned*)(F.lds + MISC_OFF);
    for (int u = F.tid; u < (LDS_BYTES - MISC_OFF) / 4; u += NWAVES * 64) ((LAS unsigned*)(F.lds + MISC_OFF))[u] = 0u;
    __syncthreads();
    XcdBarrier bar; bar.bar = (unsigned*)(ws + WS_CTL) + CW_BAR; bar.x = 0; bar.st = nullptr;
    if (MK_N_LAUNCHES == 1) bar = xcd_barrier_post((unsigned*)(ws + WS_CTL) + CW_BAR, MISC + 8);
    const int lo = args.ph_lo, hi = args.ph_hi;
#ifndef MK_PHASE_MASK
#define MK_PHASE_MASK 0x3ff
#endif
#define IN(k) (((MK_PHASE_MASK >> (k)) & 1) && lo <= (k) && (k) < hi)
#define SEAM(k) do { if (IN(k) && IN((k) + 1)) xcd_barrier(bar); } while (0)

    if (IN(0)) { p0_prologue(F); } SEAM(0);
    if (IN(1)) { p1_phase(F); } SEAM(1);
    if (IN(2)) {
        const bf16* XN = (const bf16*)(ws + WS_R1); const bf16* WIN = (const bf16*)(ws + WS_WIN_T);
        {
            pg8::Gemm g{XN, WIN, XN, WIN, MTOK, 4096, DM}; pg8::StaticOrder S; S.init(MTOK, 4096, F.G, (int)blockIdx.x);
            EpiIn E{(bf16*)(ws + WS_R2), (bf16*)(ws + WS_R3), (bf16*)F.out, (const float*)(ws + WS_BINP)};
            pg8::gemm_phase<EpiIn, pg8::StaticOrder, true, true>(F.lds, g, S, E);
        }
        {
            pg8::Gemm g{WIN + (size_t)4096 * DM, XN, WIN + (size_t)4096 * DM, XN, 3072, MTOK, DM}; pg8::StaticOrder S; S.init(3072, MTOK, F.G, (int)blockIdx.x);
            EpiPhy E{(bf16*)(ws + WS_R5), (const float*)(ws + WS_BINP) + 4096};
            pg8::gemm_phase<EpiPhy, pg8::StaticOrder, true, true>(F.lds, g, S, E);
        }
        {
            const bf16* XC = (const bf16*)(ws + WS_XC);
            pg8::Gemm g{XC, WIN, XC, WIN, MCTX, DM, DM}; pg8::StaticOrder S; S.init(MCTX, DM, F.G, (int)blockIdx.x);
            EpiIn E{(bf16*)(ws + WS_RXC), nullptr, nullptr, (const float*)(ws + WS_BINP)};
            pg8::gemm_phase<EpiIn, pg8::StaticOrder, true, true>(F.lds, g, S, E);
        }
    } SEAM(2);
    if (IN(3)) {
#ifndef MK_NO_RNN
        for (int task = blockIdx.x; task < 256; task += F.G) rnn_task(F, task);
#endif
#ifndef MK_NO_HY
        for (int grp = blockIdx.x; grp < 256; grp += F.G) hy_group(F, grp);
#endif
    } SEAM(3);
    if (IN(4)) { p4_transpose(F); } SEAM(4);
    if (IN(5)) {
        pg8::Gemm g{(const bf16*)(ws + WS_R3), (const bf16*)(ws + WS_WA_T), (const bf16*)(ws + WS_R2), (const bf16*)(ws + WS_WB_T), MTOK, DM, DM};
        DualOrder S; S.so.init(MTOK, DM, F.G, (int)blockIdx.x);
        EpiDual E{(bf16*)(ws + WS_R1), (const bf16*)F.out};
        pg8::gemm_phase<EpiDual, DualOrder, true, true>(F.lds, g, S, E);
    } SEAM(5);
    if (IN(6)) {
        const bf16* MG = (const bf16*)(ws + WS_R5 + 64 * MiB); const bf16* WO = (const bf16*)(ws + WS_WOUT_T);
        pg8::Gemm g{MG, WO, MG, WO, MTOK, DM, DM}; pg8::StaticOrder S; S.init(MTOK, DM, F.G, (int)blockIdx.x);
        EpiOut E{F.in[0], F.out, (bf16*)(ws + WS_R1), (float*)(ws + WS_SS), (const float*)(ws + WS_MOD), F.in[7]};
        pg8::gemm_phase<EpiOut, pg8::StaticOrder, true, true>(F.lds, g, S, E);
    } SEAM(6);
    if (IN(7)) {
        const bf16* A2 = (const bf16*)(ws + WS_R1); const bf16* WF = (const bf16*)(ws + WS_WFFI_T);
        pg8::Gemm g{A2, WF, A2, WF, MTOK, NFF, DM}; pg8::StaticOrder S; S.init(MTOK, NFF, F.G, (int)blockIdx.x);
        EpiFfn E{(const float*)(ws + WS_SS), (const float*)(ws + WS_BIAS2P), (bf16*)(ws + WS_R5)};
        pg8::gemm_phase<EpiFfn, pg8::StaticOrder, true, true>(F.lds, g, S, E);
    } SEAM(7);
    if (IN(8)) {
        const bf16* AC = (const bf16*)(ws + WS_R5); const bf16* WF = (const bf16*)(ws + WS_WFFO_T);
        pg8::Gemm g{AC, WF, AC, WF, MTOK, DM, DFF}; pg8::StaticOrder S; S.init(MTOK, DM, F.G, (int)blockIdx.x);
        EpiDown E{F.out, (float*)(ws + WS_SS2), (const float*)(ws + WS_MOD)};
        pg8::gemm_phase<EpiDown, pg8::StaticOrder, true, true>(F.lds, g, S, E);
    } SEAM(8);
    if (IN(9)) { p9_final(F); }
#undef IN
#undef SEAM
}

extern "C" void kernel_launch(void* const* d_in, const int* in_sizes, int n_in, void* d_out, int out_size, void* d_ws, size_t ws_size, hipStream_t stream) {
    static int grid = 0;
    if (grid == 0) {
        if (n_in != 34 || out_size != MTOK * DM || ws_size < WS_END) { fprintf(stderr, "kernel_launch: unexpected shapes (n_in %d, out %d, ws %zu)\n", n_in, out_size, ws_size); grid = -1; return; }
        int dev = 0, cus = 0, per_cu = 0;
        if (hipGetDevice(&dev) != hipSuccess || hipDeviceGetAttribute(&cus, hipDeviceAttributeMultiprocessorCount, dev) != hipSuccess) { grid = -1; return; }
        if (hipFuncSetAttribute((const void*)mk_fwd, hipFuncAttributeMaxDynamicSharedMemorySize, LDS_BYTES) != hipSuccess) { fprintf(stderr, "kernel_launch: hipFuncSetAttribute failed\n"); grid = -1; return; }
        if (hipOccupancyMaxActiveBlocksPerMultiprocessor(&per_cu, (const void*)mk_fwd, NWAVES * 64, LDS_BYTES) != hipSuccess || per_cu < 1)
            fprintf(stderr, "kernel_launch: occupancy query reports %d workgroups per CU\n", per_cu);
        (void)hipGetLastError();
        grid = cus;
    }
    if (grid < 0) return;
    if (hipMemsetAsync((char*)d_ws + WS_CTL, 0, CTL_ZERO_BYTES, stream) != hipSuccess) { fprintf(stderr, "kernel_launch: hipMemsetAsync failed\n"); return; }
    Args a{};
    for (int i = 0; i < 34; ++i) a.in[i] = (const float*)d_in[i];
    a.out = (float*)d_out; a.ws = (unsigned char*)d_ws;
    if (MK_N_LAUNCHES == 1) {
        a.ph_lo = 0; a.ph_hi = N_PHASES;
        hipLaunchKernelGGL(mk_fwd, dim3(grid), dim3(NWAVES * 64), LDS_BYTES, stream, a);
    } else {
        for (int p = 0; p < N_PHASES; ++p) { a.ph_lo = p; a.ph_hi = p + 1; hipLaunchKernelGGL(mk_fwd, dim3(grid), dim3(NWAVES * 64), LDS_BYTES, stream, a); }
    }
}
```

```cpp
#include <hip/hip_runtime.h>
#include <cstdio>
#include <cstdint>
#include <cmath>
namespace pg8 {
#define PG8_LAS __attribute__((address_space(3)))
typedef unsigned short bf16_t;
typedef short bf16x8 __attribute__((ext_vector_type(8)));
typedef float f32x4 __attribute__((ext_vector_type(4)));
typedef unsigned u32x4 __attribute__((ext_vector_type(4)));
constexpr int BM = 256, BK = 64, HALF = 128, HTB = HALF * BK * 2  , STAGE_BYTES = 8 * HTB, NXCD = 8, WGM = 8;

__host__ __device__ __forceinline__ int lds_byte(int r, int c) { const int st = (r >> 4) * 2 + (c >> 5), rr = r & 15, cc = c & 31, ob = rr * 64 + cc * 2; return st * 1024 + (ob ^ (((ob >> 9) & 1) << 5)); }
__host__ __device__ __forceinline__ void stage_rc(int b, int& R, int& C) { const int st = b / 1024, sb = b % 1024, swz = sb ^ (((sb >> 9) & 1) << 5); R = (st >> 1) * 16 + swz / 64; C = (st & 1) * 32 + (swz % 64) / 2; }
__host__ __device__ __forceinline__ int perm32(int rho) { const int n = rho >> 4, i = rho & 15; return 8 * (i >> 2) + 4 * n + (i & 3); }

struct Unit { int pm, pn, sel; };
struct Gemm { const bf16_t* A; const bf16_t* Bt; const bf16_t* A1; const bf16_t* Bt1; int M, N, K; };

struct StaticOrder {
    int nM, nN, nwg, G, c;
    __host__ __device__ __forceinline__ void init(int M, int N, int G_, int c_) { nM = M / BM; nN = N / BM; nwg = nM * nN; G = G_; c = c_; }
    __host__ __device__ __forceinline__ bool next(int i, Unit& u) const {
        const long L = (long)i * G + c; if (L >= nwg) return false;
        int wgid = (int)L; { const int q = nwg / NXCD, r = nwg % NXCD, xcd = wgid % NXCD, off = wgid / NXCD; wgid = (xcd < r ? xcd * (q + 1) : r * (q + 1) + (xcd - r) * q) + off; }
        const int nig = WGM * nN, gid = wgid / nig, fm = gid * WGM, gsz = (nM - fm) < WGM ? (nM - fm) : WGM;
        u.pm = fm + ((wgid % nig) % gsz); u.pn = (wgid % nig) / gsz; u.sel = 0; return true;
    }
    __device__ __forceinline__ void a_ready(const Unit&) const {}
    __device__ __forceinline__ void done(const Unit&) const {}
};


__device__ __forceinline__ unsigned cvt_pk_bf16(float lo, float hi) { unsigned r; asm volatile("v_cvt_pk_bf16_f32 %0, %1, %2" : "=v"(r) : "v"(lo), "v"(hi)); return r; }
template <class Epi, class Sched, bool ALIGN_EPI = false, bool SP2 = false>
__device__ __forceinline__ void gemm_phase(PG8_LAS unsigned char* lds, const Gemm g, const Sched& S, const Epi& E, const int wave_id) {
    int lane; asm volatile("v_mbcnt_lo_u32_b32 %0, -1, 0\n\tv_mbcnt_hi_u32_b32 %0, -1, %0" : "=v"(lane));
    const int wid = wave_id, tid = wid * 64 + lane, wr = wid >> 2, wc = wid & 3, fr = lane & 15, fq = lane >> 4;
    const int K = g.K, nt = K / BK;
    unsigned voffA[2], voffB[2];
#pragma unroll
    for (int i = 0; i < 2; ++i) { int R, C; stage_rc(tid * 16 + i * 8192, R, C); const int Rb = Epi::PERM ? ((R & ~31) + perm32(R & 31)) : R;
        voffA[i] = (unsigned)(R * K + C) * 2u; voffB[i] = (unsigned)(Rb * K + C) * 2u; }
    const size_t kstep = (size_t)(BK * 2);
    const size_t hstep = (size_t)HALF * K * 2;
    const size_t tstep = 2 * hstep;
    const unsigned ldsw = (unsigned)wid * 1024u;
    const int aoff = lds_byte(wr * 64 + fr, fq * 8), boff = lds_byte(wc * 32 + fr, fq * 8);
#define PG8_SA(b, h) (((b) * 2 + (h)) * HTB)
#define PG8_SB(b, h) ((4 + (b) * 2 + (h)) * HTB)
#define PG8_STAGE(bufoff, gbase, voff) do { _Pragma("unroll") for (int _i = 0; _i < 2; ++_i) \
        __builtin_amdgcn_global_load_lds((const unsigned*)((const char*)(gbase) + (voff)[_i]), (PG8_LAS unsigned*)(lds + (bufoff) + ldsw + _i * 8192), 16, 0, 0); } while (0)
#define PG8_LDA(dst, b, h) do { _Pragma("unroll") for (int m = 0; m < 4; ++m) _Pragma("unroll") for (int k = 0; k < 2; ++k) dst[m][k] = *(const PG8_LAS bf16x8*)(lds + PG8_SA(b, h) + aoff + m * 2048 + k * 1024); } while (0)
#define PG8_LDB(dst, b, h) do { _Pragma("unroll") for (int n = 0; n < 2; ++n) _Pragma("unroll") for (int k = 0; k < 2; ++k) dst[n][k] = *(const PG8_LAS bf16x8*)(lds + PG8_SB(b, h) + boff + n * 2048 + k * 1024); } while (0)
#define PG8_MMA(ai, bj, At, Bt) do { __builtin_amdgcn_s_setprio(1); _Pragma("unroll") for (int m = 0; m < 4; ++m) _Pragma("unroll") for (int n = 0; n < 2; ++n) _Pragma("unroll") for (int k = 0; k < 2; ++k) \
        acc[ai][bj][m][n] = __builtin_amdgcn_mfma_f32_16x16x32_bf16(Bt[n][k], At[m][k], acc[ai][bj][m][n], 0, 0, 0); __builtin_amdgcn_s_setprio(0); } while (0)
#define PG8_WAIT_V(n) asm volatile("s_waitcnt vmcnt(" #n ")" ::: "memory")
#define PG8_WAIT_L(n) asm volatile("s_waitcnt lgkmcnt(" #n ")" ::: "memory")
#define PG8_BAR __builtin_amdgcn_s_barrier()
#define PG8_SCHED __builtin_amdgcn_sched_barrier(0)
    Unit cur, nxt; int ui = 0;
    if (!S.next(0, cur)) return;
    f32x4 acc[2][2][4][2];
#pragma unroll
    for (int a = 0; a < 2; ++a)
#pragma unroll
        for (int b = 0; b < 2; ++b)
#pragma unroll
            for (int m = 0; m < 4; ++m)
#pragma unroll
                for (int n = 0; n < 2; ++n) acc[a][b][m][n] = (f32x4){0.f, 0.f, 0.f, 0.f};
    bf16x8 At[4][2], B0[2][2], B1[2][2];
    const char* cA = (const char*)(cur.sel ? g.A1 : g.A) + (size_t)cur.pm * tstep; const char* cB = (const char*)(cur.sel ? g.Bt1 : g.Bt) + (size_t)cur.pn * tstep;
    S.a_ready(cur);
    if constexpr (SP2) {
        PG8_STAGE(PG8_SB(0, 0), cB, voffB); PG8_STAGE(PG8_SB(0, 1), cB + hstep, voffB); PG8_STAGE(PG8_SA(0, 0), cA, voffA); PG8_STAGE(PG8_SA(0, 1), cA + hstep, voffA);
        if (wr == 1) PG8_BAR;
        PG8_WAIT_V(2); PG8_BAR;
        PG8_STAGE(PG8_SB(1, 0), cB + kstep, voffB); PG8_STAGE(PG8_SA(1, 0), cA + kstep, voffA); PG8_STAGE(PG8_SB(1, 1), cB + hstep + kstep, voffB);
        PG8_WAIT_V(6); PG8_BAR;
    } else {
        PG8_STAGE(PG8_SB(0, 0), cB, voffB); PG8_STAGE(PG8_SA(0, 0), cA, voffA); PG8_STAGE(PG8_SB(0, 1), cB + hstep, voffB); PG8_STAGE(PG8_SA(0, 1), cA + hstep, voffA);
        if (wr == 1) PG8_BAR;
        PG8_WAIT_V(4); PG8_BAR;
        PG8_STAGE(PG8_SB(1, 0), cB + kstep, voffB); PG8_STAGE(PG8_SA(1, 0), cA + kstep, voffA); PG8_STAGE(PG8_SB(1, 1), cB + hstep + kstep, voffB);
        PG8_WAIT_V(6); PG8_BAR;
    }
    for (;;) {
        const bool has_next = S.next(ui + 1, nxt);
        const char* nA = has_next ? (const char*)(nxt.sel ? g.A1 : g.A) + (size_t)nxt.pm * tstep : cA; const char* nB = has_next ? (const char*)(nxt.sel ? g.Bt1 : g.Bt) + (size_t)nxt.pn * tstep : cB;
        for (int t = 0; t < nt; t += 2) {
            const bool last = (t == nt - 2);
            const char* a1 = cA + (size_t)(t + 1) * kstep;
            const char* a2 = last ? nA : cA + (size_t)(t + 2) * kstep; const char* b2 = last ? nB : cB + (size_t)(t + 2) * kstep;
            const char* a3 = a2 + kstep; const char* b3 = b2 + kstep;
            if (last && has_next) S.a_ready(nxt);
            if constexpr (SP2) {
            PG8_LDB(B0, 0, 0); PG8_LDB(B1, 0, 1); PG8_SCHED; PG8_LDA(At, 0, 0); PG8_STAGE(PG8_SA(1, 1), a1 + hstep, voffA);
            PG8_WAIT_V(8); PG8_WAIT_L(0); PG8_BAR; PG8_MMA(0, 0, At, B0); PG8_MMA(0, 1, At, B1); PG8_BAR; PG8_SCHED;
            PG8_LDA(At, 0, 1); PG8_STAGE(PG8_SB(0, 0), b2, voffB); PG8_STAGE(PG8_SB(0, 1), b2 + hstep, voffB); PG8_STAGE(PG8_SA(0, 0), a2, voffA);
            PG8_WAIT_V(8); PG8_WAIT_L(0); PG8_BAR; PG8_MMA(1, 0, At, B0); PG8_MMA(1, 1, At, B1); PG8_BAR; PG8_SCHED;
            PG8_LDB(B0, 1, 0); PG8_LDB(B1, 1, 1); PG8_SCHED; PG8_LDA(At, 1, 0); PG8_STAGE(PG8_SA(0, 1), a2 + hstep, voffA);
            PG8_WAIT_V(8); PG8_WAIT_L(0); PG8_BAR; PG8_MMA(0, 0, At, B0); PG8_MMA(0, 1, At, B1); PG8_BAR; PG8_SCHED;
            PG8_LDA(At, 1, 1); PG8_STAGE(PG8_SB(1, 0), b3, voffB); PG8_STAGE(PG8_SB(1, 1), b3 + hstep, voffB); PG8_STAGE(PG8_SA(1, 0), a3, voffA);
            PG8_WAIT_V(8); PG8_WAIT_L(0); PG8_BAR; PG8_MMA(1, 0, At, B0); PG8_MMA(1, 1, At, B1); PG8_BAR; PG8_SCHED;
            } else {
            PG8_LDB(B0, 0, 0); PG8_SCHED; PG8_LDA(At, 0, 0); PG8_STAGE(PG8_SA(1, 1), a1 + hstep, voffA);
            PG8_WAIT_L(8); PG8_BAR; PG8_WAIT_L(0); PG8_MMA(0, 0, At, B0); PG8_BAR; PG8_SCHED;
            PG8_LDB(B1, 0, 1); PG8_STAGE(PG8_SB(0, 0), b2, voffB);
            PG8_BAR; PG8_WAIT_L(0); PG8_MMA(0, 1, At, B1); PG8_BAR;
            PG8_LDA(At, 0, 1); PG8_STAGE(PG8_SA(0, 0), a2, voffA);
            PG8_BAR; PG8_WAIT_L(0); PG8_MMA(1, 0, At, B0); PG8_BAR; PG8_SCHED;
            PG8_STAGE(PG8_SB(0, 1), b2 + hstep, voffB);
            PG8_WAIT_V(6); PG8_BAR; PG8_MMA(1, 1, At, B1); PG8_BAR;
            PG8_LDB(B0, 1, 0); PG8_SCHED; PG8_LDA(At, 1, 0); PG8_STAGE(PG8_SA(0, 1), a2 + hstep, voffA);
            PG8_WAIT_L(8); PG8_BAR; PG8_WAIT_L(0); PG8_MMA(0, 0, At, B0); PG8_BAR; PG8_SCHED;
            PG8_LDB(B1, 1, 1); PG8_STAGE(PG8_SB(1, 0), b3, voffB);
            PG8_BAR; PG8_WAIT_L(0); PG8_MMA(0, 1, At, B1); PG8_BAR;
            PG8_LDA(At, 1, 1); PG8_STAGE(PG8_SA(1, 0), a3, voffA);
            PG8_BAR; PG8_WAIT_L(0); PG8_MMA(1, 0, At, B0); PG8_BAR; PG8_SCHED;
            PG8_STAGE(PG8_SB(1, 1), b3 + hstep, voffB);
            PG8_WAIT_V(6); PG8_BAR; PG8_MMA(1, 1, At, B1); PG8_BAR;
            }
        }
        if constexpr (ALIGN_EPI) { if (wr == 0) PG8_BAR; }
        if constexpr (!Epi::AFTER_DRAIN) { E(acc, cur, wr, wc, fr, fq); S.done(cur); }
        if (!has_next) break;
#pragma unroll
        for (int a = 0; a < 2; ++a)
#pragma unroll
            for (int b = 0; b < 2; ++b)
#pragma unroll
                for (int m = 0; m < 4; ++m)
#pragma unroll
                    for (int n = 0; n < 2; ++n) acc[a][b][m][n] = (f32x4){0.f, 0.f, 0.f, 0.f};
        cur = nxt; cA = nA; cB = nB; ++ui;
        if constexpr (ALIGN_EPI) { if (wr == 1) PG8_BAR; }
    }
    PG8_WAIT_V(0);
    if constexpr (!ALIGN_EPI) { if (wr == 0) PG8_BAR; }
    PG8_BAR;
    if constexpr (Epi::AFTER_DRAIN) { E.fused(acc, cur, wr, wc, fr, fq, lds, wid, lane); S.done(cur); }
#undef PG8_SA
#undef PG8_SB
#undef PG8_STAGE
#undef PG8_LDA
#undef PG8_LDB
#undef PG8_MMA
#undef PG8_WAIT_V
#undef PG8_WAIT_L
#undef PG8_BAR
#undef PG8_SCHED
}
}

#define GAS __attribute__((address_space(1)))
#define LAS __attribute__((address_space(3)))
typedef unsigned short bf16;
typedef unsigned v4u __attribute__((ext_vector_type(4)));
typedef float f32x4 __attribute__((ext_vector_type(4)));
typedef short bf16x8 __attribute__((ext_vector_type(8)));
typedef GAS unsigned gu32;
typedef GAS unsigned long long gu64;
#define RLX_AGENT __ATOMIC_RELAXED, __HIP_MEMORY_SCOPE_AGENT
#define LDS_WAIT() asm volatile("s_waitcnt lgkmcnt(0)" ::: "memory")
#define VM_WAIT() asm volatile("s_waitcnt vmcnt(0)" ::: "memory")
__device__ __forceinline__ unsigned long long rt() { return __builtin_amdgcn_s_memrealtime(); }
__device__ __forceinline__ unsigned f2bf(float f) { unsigned u = __builtin_bit_cast(unsigned, f); return (u + 0x7fffu + ((u >> 16) & 1u)) >> 16; }
__device__ __forceinline__ unsigned pk2(float lo, float hi) { return f2bf(lo) | (f2bf(hi) << 16); }

#define XB_TMO      128
#define XB_XCNT(j)  (256  + 64 * (j))
#define XB_XSUB(j)  (1280 + 64 * (j))
#define XB_XGEN(j)  (2304 + 64 * (j))
#define XB_TOP      3328
#define XB_TOPGEN   3392
#define XCD_BAR_WORDS 3456
#define XB_SPIN_CAP (1u << 18)

__device__ __forceinline__ unsigned xb_ld(unsigned* p)              { return __hip_atomic_load(p, __ATOMIC_RELAXED, __HIP_MEMORY_SCOPE_AGENT); }
__device__ __forceinline__ unsigned xb_add(unsigned* p, unsigned v) { return __hip_atomic_fetch_add(p, v, __ATOMIC_RELAXED, __HIP_MEMORY_SCOPE_AGENT); }
__device__ __forceinline__ unsigned xb_xcc_id() { return (unsigned)__builtin_amdgcn_s_getreg((3 << 11) | 20) & 0xFu; }
#define XB_SPIN(cond, bar) do { unsigned _sp = 0; while (cond) { __builtin_amdgcn_s_sleep(1); \
    if ((++_sp & 255u) == 0u) { if (xb_ld(&(bar)[XB_TMO])) break; if (_sp > XB_SPIN_CAP) { atomicAdd(&(bar)[XB_TMO], 1u); break; } } } } while (0)

__device__ __forceinline__ int xb_lane() { int l; asm volatile("v_mbcnt_lo_u32_b32 %0, -1, 0\n\tv_mbcnt_hi_u32_b32 %0, -1, %0" : "=v"(l)); return l; }
struct XcdBarrier {
    int wave;
    unsigned* bar; unsigned x;
    volatile LAS unsigned* st;
};

__device__ __forceinline__ XcdBarrier xcd_barrier_post(unsigned* bar, volatile LAS unsigned* st, int wave) {
    XcdBarrier b; b.wave = wave; b.bar = bar; b.x = xb_xcc_id(); b.st = st;
    if (wave == 0 && xb_lane() == 0) (void)xb_add(&bar[XB_XCNT(b.x)], 1u);
    return b;
}
__device__ __forceinline__ void xcd_barrier_complete(unsigned* bar, unsigned x, unsigned& nloc, unsigned& nx) {
    const unsigned G = gridDim.x * gridDim.y * gridDim.z;
    unsigned sum, cnt, mine, sp = 0u;
    for (;;) {
        sum = 0u; cnt = 0u; mine = 0u;
#pragma unroll
        for (unsigned j = 0; j < 16; ++j) { const unsigned c = xb_ld(&bar[XB_XCNT(j)]); sum += c; cnt += (c > 0u) ? 1u : 0u; mine = (j == x) ? c : mine; }
        if (sum == G) break;
        __builtin_amdgcn_s_sleep(1);
        if ((++sp & 255u) == 0u) { if (xb_ld(&bar[XB_TMO])) break; if (sp > XB_SPIN_CAP) { atomicAdd(&bar[XB_TMO], 1u); break; } }
    }
    nloc = mine > 0u ? mine : 1u; nx = cnt > 0u ? cnt : 1u;
}

__device__ __forceinline__ void xcd_barrier(const XcdBarrier& b) {
    asm volatile("s_waitcnt vmcnt(0)" ::: "memory");
    __syncthreads();
    if (b.wave == 0 && xb_lane() == 0) {
        unsigned* bar = b.bar;
        __builtin_amdgcn_s_waitcnt(0);
        unsigned nloc = b.st[0], nx = b.st[1];
        if (nloc == 0u) { xcd_barrier_complete(bar, b.x, nloc, nx); b.st[0] = nloc; b.st[1] = nx; }
        const unsigned old = xb_add(&bar[XB_XSUB(b.x)], 1u);
        const unsigned gen = old / nloc;
        if (old + 1u == (gen + 1u) * nloc) {
            __builtin_amdgcn_fence(__ATOMIC_RELEASE, "agent");
            asm volatile("s_waitcnt vmcnt(0)" ::: "memory");
            const unsigned og = xb_add(&bar[XB_TOP], 1u);
            const unsigned tg = og / nx;
            if (og + 1u == (tg + 1u) * nx) xb_add(&bar[XB_TOPGEN], 1u);
            else XB_SPIN(xb_ld(&bar[XB_TOPGEN]) == tg, bar);
            __builtin_amdgcn_fence(__ATOMIC_ACQUIRE, "agent");
            xb_add(&bar[XB_XGEN(b.x)], 1u);
            asm volatile("s_waitcnt vmcnt(0)" ::: "memory");
        } else {
            XB_SPIN(xb_ld(&bar[XB_XGEN(b.x)]) == gen, bar);
            __builtin_amdgcn_fence(__ATOMIC_ACQUIRE, "agent");
            asm volatile("s_waitcnt vmcnt(0)" ::: "memory");
        }
    }
    __syncthreads();
}

#define HD __host__ __device__ __forceinline__
#ifndef HD
#define HD __host__ __device__ __forceinline__
#endif
typedef float cf __attribute__((ext_vector_type(2)));
#if defined(__HIP_DEVICE_COMPILE__)
#define FFT_OPAQUE(w) asm volatile("" : "+v"(w.x), "+v"(w.y))
#else
#define FFT_OPAQUE(w)
#endif
HD cf cmk(float x, float y) { cf r; r.x = x; r.y = y; return r; }
HD cf cadd(cf a, cf b) { return cmk(a.x + b.x, a.y + b.y); }
HD cf csub(cf a, cf b) { return cmk(a.x - b.x, a.y - b.y); }
HD cf cmul(cf a, cf b) { return cmk(a.x * b.x - a.y * b.y, a.x * b.y + a.y * b.x); }
HD cf cconj(cf a) { return cmk(a.x, -a.y); }
template <bool INV> HD cf mul_mi(cf a) { return INV ? cmk(-a.y, a.x) : cmk(a.y, -a.x); }

template <bool INV> HD void dft4(cf& a, cf& b, cf& c, cf& d) {
    const cf s0 = cadd(a, c), s1 = csub(a, c), s2 = cadd(b, d), s3 = mul_mi<INV>(csub(b, d));
    a = cadd(s0, s2); c = csub(s0, s2); b = cadd(s1, s3); d = csub(s1, s3);
}
template <bool INV> HD void dft16(cf (&x)[16]) {
    const float C1 = 0.92387953251128674f, S1 = 0.38268343236508977f, R2 = 0.70710678118654752f;
#pragma unroll
    for (int na = 0; na < 4; ++na) dft4<INV>(x[na], x[na + 4], x[na + 8], x[na + 12]);
#define TW16(idx, cr, ci) x[idx] = cmul(x[idx], cmk(cr, INV ? -(ci) : (ci)))
    TW16(1 + 4 * 1, C1, -S1);  TW16(1 + 4 * 2, R2, -R2);  TW16(1 + 4 * 3, S1, -C1);
    TW16(2 + 4 * 1, R2, -R2);  TW16(2 + 4 * 2, 0.f, -1.f); TW16(2 + 4 * 3, -R2, -R2);
    TW16(3 + 4 * 1, S1, -C1);  TW16(3 + 4 * 2, -R2, -R2); TW16(3 + 4 * 3, -C1, S1);
#undef TW16
    cf y[16];
#pragma unroll
    for (int kb = 0; kb < 4; ++kb) {
        cf a = x[0 + 4 * kb], b = x[1 + 4 * kb], c = x[2 + 4 * kb], d = x[3 + 4 * kb];
        dft4<INV>(a, b, c, d);
        y[kb + 0] = a; y[kb + 4] = b; y[kb + 8] = c; y[kb + 12] = d;
    }
#pragma unroll
    for (int i = 0; i < 16; ++i) x[i] = y[i];
}
HD void tw_chain(cf (&x)[16], cf base) {
    FFT_OPAQUE(base);
    cf w = base;
#pragma unroll
    for (int j = 1; j < 16; ++j) { x[j] = cmul(x[j], w); if (j < 15) w = cmul(w, base); }
}
HD void tw_chain2(cf (&x)[16], cf start, cf step) {
    FFT_OPAQUE(start); FFT_OPAQUE(step);
    cf w = start;
#pragma unroll
    for (int j = 0; j < 16; ++j) { x[j] = cmul(x[j], w); if (j < 15) w = cmul(w, step); }
}
HD cf cis_pi(float frac) {
    float s, c;
#if defined(__HIP_DEVICE_COMPILE__)
    sincospif(frac, &s, &c);
#else
    s = (float)sin(3.14159265358979323846 * (double)frac); c = (float)cos(3.14159265358979323846 * (double)frac);
#endif
    return cmk(c, s);
}
constexpr int FFT_BUF_ELEMS = 16 * 272;
HD int lay1(int n0, int n1, int k0) { return n0 + 16 * n1 + 272 * k0; }
HD int lay2(int k1, int n0, int k0) { return k1 + 17 * n0 + 272 * k0; }

struct FftTw { cf bA, bB, bIBs, bIBt, wb; };
HD FftTw fft_make_tw(int ht) {
    FftTw T; const int lo = ht & 15, hi = ht >> 4;
    T.bA = cis_pi(-(float)ht * (1.0f / 2048.0f));
    T.bB = cis_pi(-(float)lo * (1.0f / 128.0f));
    T.bIBs = cis_pi((float)(lo * hi) * (1.0f / 2048.0f));
    T.bIBt = cis_pi((float)hi * (1.0f / 128.0f));
    T.wb = cis_pi(-(float)ht * (1.0f / 4096.0f));
    return T;
}
template <class BUF> HD void fft_fA(cf (&x)[16], int ht, BUF buf, const FftTw& T) {
    dft16<false>(x);
    tw_chain(x, T.bA);
    const int n0 = ht & 15, n1 = ht >> 4;
#pragma unroll
    for (int k0 = 0; k0 < 16; ++k0) buf[lay1(n0, n1, k0)] = x[k0];
}
template <class BUF> HD void fft_fB(cf (&x)[16], int ht, BUF bufin, BUF bufout, const FftTw& T) {
    const int n0 = ht & 15, k0 = ht >> 4;
#pragma unroll
    for (int n1 = 0; n1 < 16; ++n1) x[n1] = bufin[lay1(n0, n1, k0)];
    dft16<false>(x);
    tw_chain(x, T.bB);
#pragma unroll
    for (int k1 = 0; k1 < 16; ++k1) bufout[lay2(k1, n0, k0)] = x[k1];
}
template <class BUF> HD void fft_fC(cf (&x)[16], int ht, BUF bufin) {
    const int k1 = ht & 15, k0 = ht >> 4;
#pragma unroll
    for (int n0 = 0; n0 < 16; ++n0) x[n0] = bufin[lay2(k1, n0, k0)];
    dft16<false>(x);
}
template <class BUF> HD void fft_iA(cf (&x)[16], int ht, BUF bufout, const FftTw& T) {
    const int k1 = ht & 15, k0 = ht >> 4;
    dft16<true>(x);
    tw_chain(x, cconj(T.bB));
#pragma unroll
    for (int n0 = 0; n0 < 16; ++n0) bufout[lay2(k1, n0, k0)] = x[n0];
}
template <class BUF> HD void fft_iB(cf (&x)[16], int ht, BUF bufin, BUF bufout, const FftTw& T) {
    const int n0 = ht & 15, k0 = ht >> 4;
#pragma unroll
    for (int k1 = 0; k1 < 16; ++k1) x[k1] = bufin[lay2(k1, n0, k0)];
    dft16<true>(x);
    tw_chain2(x, T.bIBs, T.bIBt);
#pragma unroll
    for (int n1 = 0; n1 < 16; ++n1) bufout[lay1(n0, n1, k0)] = x[n1];
}
template <class BUF> HD void fft_iC(cf (&x)[16], int ht, BUF bufin) {
    const int n0 = ht & 15, n1 = ht >> 4;
#pragma unroll
    for (int k0 = 0; k0 < 16; ++k0) x[k0] = bufin[lay1(n0, n1, k0)];
    dft16<true>(x);
}

constexpr int NWAVES = 8;
#ifndef MK_N_LAUNCHES
#define MK_N_LAUNCHES 1
#endif
constexpr int N_PHASES = 10;
constexpr int NB = 8, SEQ = 4096, DM = 1024, MTOK = NB * SEQ, CTXL = 256, MCTX = NB * CTXL;
constexpr int DIN = 7168, DFF = 2816, NFF = 5632, NMOD = 6144;
constexpr float RMS_EPS = 1e-6f;
constexpr float LOG2E = 1.4426950408889634f;

constexpr size_t MiB = 1u << 20;
constexpr size_t WS_CTL = 0, CTL_ZERO_BYTES = 64 * 1024;
constexpr size_t WS_MOD = 1 * MiB;
constexpr size_t WS_BIAS2P = 1 * MiB + 256 * 1024;
constexpr size_t WS_BINP = 1 * MiB + 512 * 1024;
constexpr size_t WS_SS = 2 * MiB;
constexpr size_t WS_SS2 = 4 * MiB;
constexpr size_t WS_HDN = 6 * MiB;
constexpr size_t WS_WA_T = 8 * MiB, WS_WB_T = 10 * MiB, WS_WOUT_T = 12 * MiB;
constexpr size_t WS_WFFI_T = 14 * MiB;
constexpr size_t WS_WFFO_T = 25 * MiB;
constexpr size_t WS_WIN_T = 31 * MiB;
constexpr size_t WS_XC = 45 * MiB;
constexpr size_t WS_RXC = 49 * MiB;
constexpr size_t WS_SCR = 53 * MiB;
constexpr size_t SCR_PER_BLOCK = 256 * 1024;
constexpr size_t WS_R1 = 117 * MiB;
constexpr size_t WS_R2 = 181 * MiB;
constexpr size_t WS_R3 = 245 * MiB;
constexpr size_t WS_R5 = 309 * MiB;
constexpr size_t WS_END = 501 * MiB;
constexpr int CW_BAR = 1024;

constexpr int LDS_BYTES = 147456;
constexpr int SMALL_OFF = 139264;
constexpr int MISC_OFF = 147200;

struct Frame {
    LAS unsigned char* lds;
    int wave, G, vcu, flags;
    const float* const* in;
    float* out; unsigned char* ws;
};

__device__ __forceinline__ int fresh_lane() { int l; asm volatile("v_mbcnt_lo_u32_b32 %0, -1, 0\n\tv_mbcnt_hi_u32_b32 %0, -1, %0" : "=v"(l)); return l; }
#define FLANE fresh_lane()
#define FTID (F.wave * 64 + fresh_lane())
__device__ __forceinline__ float bf2f(unsigned h) { return __uint_as_float(h << 16); }
__device__ __forceinline__ float sigmoidf_fast(float x) { return __builtin_amdgcn_rcpf(1.0f + __builtin_amdgcn_exp2f(-x * LOG2E)); }
__device__ __forceinline__ float siluf_fast(float x) { return x * sigmoidf_fast(x); }
__device__ __forceinline__ float gelu_tanh_fast(float x) { const float u = 1.5957691216057308f * (x + 0.044715f * x * x * x); return x * sigmoidf_fast(u); }
__device__ __forceinline__ float wave_sum(float v) {
#pragma unroll
    for (int o = 1; o < 64; o <<= 1) v += __shfl_xor(v, o);
    return v;
}
__device__ __forceinline__ int src_col_win(int n) { return n < 2048 ? n : (n < 4096 ? n + 3072 : n - 2048); }
__device__ __forceinline__ int src_col_ffi(int n) { const int g = n >> 5, i = n & 31; return i < 16 ? 16 * g + i : DFF + 16 * g + (i - 16); }
__device__ __forceinline__ int new_col_ffi(int n) { const int j = n < DFF ? n : n - DFF; return 32 * (j >> 4) + (n < DFF ? 0 : 16) + (j & 15); }

template <int MAP>
__device__ __forceinline__ void p0_transpose_item(const float* W, int K, int N, bf16* WT, LAS float* scr, int item, int nblk, int lane) {
    const int kb = item / nblk, nb = item % nblk, k0 = 64 * kb, n0 = 32 * nb;
    const int nn = n0 + (lane & 31);
    const int sc = MAP == 1 ? src_col_win(nn) : (MAP == 2 ? src_col_ffi(nn) : nn);
#pragma unroll 8
    for (int i = 0; i < 32; ++i) { const int kk = 2 * i + (lane >> 5); scr[kk * 33 + (lane & 31)] = W[(size_t)(k0 + kk) * N + sc]; }
    LDS_WAIT(); asm volatile("" ::: "memory");
    const int c = lane & 7;
#pragma unroll
    for (int j = 0; j < 4; ++j) { const int n = (lane >> 3) + 8 * j; const LAS float* s = scr + (8 * c) * 33 + n;
        v4u o; o.x = pk2(s[0 * 33], s[1 * 33]); o.y = pk2(s[2 * 33], s[3 * 33]); o.z = pk2(s[4 * 33], s[5 * 33]); o.w = pk2(s[6 * 33], s[7 * 33]);
        *(GAS v4u*)(WT + (size_t)(n0 + n) * K + k0 + 8 * c) = o; }
    LDS_WAIT(); asm volatile("" ::: "memory");
}
template <class OutFn>
__device__ __forceinline__ void gemv64(Frame& F, const LAS float* S, const float* W, int N, int col0, LAS float* red, OutFn out) {
    const int col = col0 + FLANE; const int k0 = F.wave * 128;
    float acc[9];
#pragma unroll
    for (int r = 0; r < 9; ++r) acc[r] = 0.f;
    const GAS float* wp = (const GAS float*)W + (size_t)k0 * N + col;
#pragma unroll 8
    for (int k = 0; k < 128; ++k) { const float w = wp[(size_t)k * N];
#pragma unroll
        for (int r = 0; r < 9; ++r) acc[r] += S[r * 1024 + k0 + k] * w; }
#pragma unroll
    for (int r = 0; r < 9; ++r) red[(F.wave * 9 + r) * 64 + FLANE] = acc[r];
    __syncthreads();
    for (int idx = FTID; idx < 576; idx += 512) { const int r = idx >> 6, c = idx & 63; float s = 0.f;
#pragma unroll
        for (int w = 0; w < 8; ++w) s += red[(w * 9 + r) * 64 + c];
        out(r, col0 + c, s); }
    __syncthreads();
}
__device__ __forceinline__ void p0_hdn_row(Frame& F, int t) {
    const float* w1 = F.in[19]; const float* b1 = F.in[20]; const float* w2 = F.in[21]; const float* b2 = F.in[22];
    const float* w3 = F.in[23]; const float* b3 = F.in[24]; const float* fq_ = F.in[25];
    const int lane = FLANE; const float freq = fq_[lane];
    float zv = 0.f;
    if (lane == 0) zv = (float)t * (1.0f / 4095.0f);
    else if (lane < 33) { const int j = (lane - 1) & 15; const double fj = 1e-4 + (double)j * ((15.0 - 1e-4) / 15.0);
        double ph = fj * (double)t * (1.0 / 4096.0); ph -= floor(ph); float s, c; sincospif(2.0f * (float)ph, &s, &c); zv = lane < 17 ? c : -s; }
    float a = b1[lane];
#pragma unroll
    for (int i = 0; i < 33; ++i) a += __int_as_float(__builtin_amdgcn_readlane(__float_as_int(zv), i)) * w1[i * 64 + lane];
    float h = __sinf(freq * a);
    a = b2[lane];
#pragma unroll
    for (int i = 0; i < 64; ++i) a += __int_as_float(__builtin_amdgcn_readlane(__float_as_int(h), i)) * w2[i * 64 + lane];
    h = __sinf(freq * a);
    a = b3[lane];
#pragma unroll
    for (int i = 0; i < 64; ++i) a += __int_as_float(__builtin_amdgcn_readlane(__float_as_int(h), i)) * w3[i * 64 + lane];
    h = __sinf(freq * a);
    ((bf16*)(F.ws + WS_HDN))[t * 64 + lane] = (bf16)f2bf(h);
}
__device__ __forceinline__ void p0_prologue(Frame& F) {
    const int gw = F.vcu * NWAVES + F.wave, NGW = F.G * NWAVES;
    {
        LAS float* S = (LAS float*)F.lds; LAS float* red = (LAS float*)(F.lds + 36864);
        if ((int)blockIdx.x < NMOD / 64) {
            const float* c = F.in[1]; const float* cc = F.in[3];
            for (int idx = FTID; idx < 9 * 1024; idx += 512) { const float v = idx < 8192 ? c[idx] : cc[idx - 8192]; S[idx] = siluf_fast(v); }
            __syncthreads();
            float* MOD = (float*)(F.ws + WS_MOD); const float* bm = F.in[5];
            for (int it = blockIdx.x; it < NMOD / 64; it += F.G)
                gemv64(F, S, F.in[4], NMOD, it * 64, red, [&](int r, int n, float s) { MOD[r * NMOD + n] = s + bm[n]; });
        }
        __syncthreads();
    }
    {
        LAS float* scr = (LAS float*)(F.lds + 57344 + F.wave * 8704);
        constexpr int I_IN = 16 * (DIN / 32), I_SQ = 16 * 32, I_FI = 16 * (NFF / 32), I_FO = (DFF / 64) * 32;
        constexpr int NITEMS = I_IN + 3 * I_SQ + I_FI + I_FO;
        for (int it = gw; it < NITEMS; it += NGW) {
            int r = it;
            if (r < I_IN) { p0_transpose_item<1>(F.in[8], DM, DIN, (bf16*)(F.ws + WS_WIN_T), scr, r, DIN / 32, FLANE); continue; } r -= I_IN;
            if (r < I_SQ) { p0_transpose_item<0>(F.in[28], DM, DM, (bf16*)(F.ws + WS_WA_T), scr, r, 32, FLANE); continue; } r -= I_SQ;
            if (r < I_SQ) { p0_transpose_item<0>(F.in[29], DM, DM, (bf16*)(F.ws + WS_WB_T), scr, r, 32, FLANE); continue; } r -= I_SQ;
            if (r < I_SQ) { p0_transpose_item<0>(F.in[30], DM, DM, (bf16*)(F.ws + WS_WOUT_T), scr, r, 32, FLANE); continue; } r -= I_SQ;
            if (r < I_FI) { p0_transpose_item<2>(F.in[31], DM, NFF, (bf16*)(F.ws + WS_WFFI_T), scr, r, NFF / 32, FLANE); continue; } r -= I_FI;
            p0_transpose_item<0>(F.in[32], DFF, DM, (bf16*)(F.ws + WS_WFFO_T), scr, r, 32, FLANE);
        }
    }
    for (int t = gw; t < SEQ; t += NGW) p0_hdn_row(F, t);
    { float* BINP = (float*)(F.ws + WS_BINP); const float* bin = F.in[9];
      for (int n = blockIdx.x * 512 + FTID; n < DIN; n += F.G * 512) BINP[n] = bin[src_col_win(n)]; }
}
__device__ __forceinline__ void p1_norm_row(Frame& F, const float* xrow, bf16* orow, const float* g, const float* sh, const float* sc) {
    const GAS f32x4* xr = (const GAS f32x4*)xrow + FLANE;
    f32x4 v[4]; float s = 0.f;
#pragma unroll
    for (int j = 0; j < 4; ++j) { v[j] = xr[64 * j]; s += (v[j].x * v[j].x + v[j].y * v[j].y) + (v[j].z * v[j].z + v[j].w * v[j].w); }
    const float rstd = 1.0f / sqrtf(wave_sum(s) * (1.0f / DM) + RMS_EPS);
    GAS unsigned long long* o8 = (GAS unsigned long long*)orow + FLANE;
#pragma unroll
    for (int j = 0; j < 4; ++j) {
        const f32x4 gg = ((const GAS f32x4*)g)[64 * j + FLANE], ss = ((const GAS f32x4*)sh)[64 * j + FLANE], cc = ((const GAS f32x4*)sc)[64 * j + FLANE];
        const float a = v[j].x * rstd * gg.x * (1.f + cc.x) + ss.x, b = v[j].y * rstd * gg.y * (1.f + cc.y) + ss.y;
        const float c = v[j].z * rstd * gg.z * (1.f + cc.z) + ss.z, d = v[j].w * rstd * gg.w * (1.f + cc.w) + ss.w;
        o8[64 * j] = (unsigned long long)pk2(a, b) | ((unsigned long long)pk2(c, d) << 32);
    }
}
__device__ __forceinline__ void p1_phase(Frame& F) {
    const int gw = F.vcu * NWAVES + F.wave, NGW = F.G * NWAVES;
    const float* MOD = (const float*)(F.ws + WS_MOD);
    {
        LAS float* S = (LAS float*)F.lds; LAS float* red = (LAS float*)(F.lds + 36864);
        if ((int)blockIdx.x < NFF / 64) {
            for (int idx = FTID; idx < 9 * 1024; idx += 512) { const int r = idx >> 10, k = idx & 1023; S[idx] = r < 8 ? MOD[r * NMOD + 3072 + k] : 0.f; }
            __syncthreads();
            float* B2 = (float*)(F.ws + WS_BIAS2P);
            for (int it = blockIdx.x; it < NFF / 64; it += F.G)
                gemv64(F, S, F.in[31], NFF, it * 64, red, [&](int r, int n, float s) { if (r < 8) B2[r * NFF + new_col_ffi(n)] = s; });
        }
        __syncthreads();
    }
    const float* g1n = F.in[6];
    bf16* XN = (bf16*)(F.ws + WS_R1); bf16* XC = (bf16*)(F.ws + WS_XC);
    for (int m = gw; m < MTOK + MCTX; m += NGW) {
        if (m < MTOK) { const int b = m >> 12; p1_norm_row(F, F.in[0] + (size_t)m * DM, XN + (size_t)m * DM, g1n, MOD + b * NMOD, MOD + b * NMOD + 1024); }
        else { const int mc = m - MTOK; p1_norm_row(F, F.in[2] + (size_t)mc * DM, XC + (size_t)mc * DM, g1n, MOD + 8 * NMOD, MOD + 8 * NMOD + 1024); }
    }
}
using pg8::f32x4; using pg8::u32x4; using pg8::Unit; using pg8::cvt_pk_bf16;
typedef unsigned u32x2v __attribute__((ext_vector_type(2)));

template <int CTRL> __device__ __forceinline__ float dpp_rot(float v) { return __int_as_float(__builtin_amdgcn_update_dpp(0, __float_as_int(v), CTRL, 0xF, 0xF, false)); }
template <bool CONV>
struct EpiIn {
    static constexpr bool PERM = true, AFTER_DRAIN = false;
    bf16* RX; bf16* RG; bf16* BG; const float* binp; const float* cw; const float* cb;
    __device__ __forceinline__ void operator()(const f32x4 (&acc)[2][2][4][2], const Unit& u, int wr, int wc, int fr, int fq) const {
        const int row0 = u.pm * 256 + wr * 64 + fr; const int colt = u.pn * 256; const int region = u.pn >> 2;
        const int col0 = colt + wc * 32 + 8 * fq;
        bf16* base; int ld, c0;
        if (region == 0) { base = RX; ld = DM; c0 = col0; } else if (region == 1) { base = RG; ld = DM; c0 = col0 - 1024; } else { base = BG; ld = 2048; c0 = col0 - 2048; }
        f32x4 bv[2][2];
#pragma unroll
        for (int bj = 0; bj < 2; ++bj)
#pragma unroll
            for (int n = 0; n < 2; ++n) bv[bj][n] = *(const f32x4*)(binp + col0 + bj * 128 + 4 * n);
        if (CONV && region == 0) {
#pragma unroll
            for (int ai = 0; ai < 2; ++ai)
#pragma unroll
                for (int bj = 0; bj < 2; ++bj) {
                    u32x2v pk[4][2];
#pragma unroll
                    for (int n = 0; n < 2; ++n) {
                        const int c = col0 + bj * 128 + 4 * n;
                        const f32x4 w0 = *(const f32x4*)(cw + c), w1 = *(const f32x4*)(cw + 1024 + c), w2 = *(const f32x4*)(cw + 2048 + c), w3 = *(const f32x4*)(cw + 3072 + c), cbv = *(const f32x4*)(cb + c);
                        float o[4][4];
#pragma unroll
                        for (int e = 0; e < 4; ++e) {
                            float x[4], r1[4], r2[4], l1[4];
#pragma unroll
                            for (int m = 0; m < 4; ++m) { x[m] = acc[ai][bj][m][n][e] + bv[bj][n][e];
                                r1[m] = dpp_rot<0x121>(x[m]); r2[m] = dpp_rot<0x122>(x[m]); l1[m] = dpp_rot<0x12F>(x[m]); }
#pragma unroll
                            for (int m = 0; m < 4; ++m) {
                                const float xm1 = fr >= 1 ? r1[m] : (m > 0 ? r1[m - 1] : 0.f);
                                const float xm2 = fr >= 2 ? r2[m] : (m > 0 ? r2[m - 1] : 0.f);
                                const float xp1 = fr <= 14 ? l1[m] : (m < 3 ? l1[m + 1] : 0.f);
                                o[m][e] = cbv[e] + w0[e] * xm2 + w1[e] * xm1 + w2[e] * x[m] + w3[e] * xp1;
                            }
                        }
#pragma unroll
                        for (int m = 0; m < 4; ++m) { pk[m][n].x = cvt_pk_bf16(o[m][0], o[m][1]); pk[m][n].y = cvt_pk_bf16(o[m][2], o[m][3]); }
                    }
#pragma unroll
                    for (int m = 0; m < 4; ++m) { u32x4 w; w.x = pk[m][0].x; w.y = pk[m][0].y; w.z = pk[m][1].x; w.w = pk[m][1].y;
                        *(u32x4*)(base + (size_t)(row0 + ai * 128 + m * 16) * ld + c0 + bj * 128) = w; }
                }
            return;
        }
#pragma unroll
        for (int ai = 0; ai < 2; ++ai)
#pragma unroll
            for (int m = 0; m < 4; ++m) { bf16* rowp = base + (size_t)(row0 + ai * 128 + m * 16) * ld + c0;
#pragma unroll
                for (int bj = 0; bj < 2; ++bj) { f32x4 v0 = acc[ai][bj][m][0] + bv[bj][0], v1 = acc[ai][bj][m][1] + bv[bj][1];
                    if (region == 1) {
#pragma unroll
                        for (int e = 0; e < 4; ++e) { v0[e] = gelu_tanh_fast(v0[e]); v1[e] = gelu_tanh_fast(v1[e]); }
                    } else if (region >= 2) {
#pragma unroll
                        for (int e = 0; e < 4; ++e) { v0[e] = sigmoidf_fast(v0[e]); v1[e] = sigmoidf_fast(v1[e]); }
                    }
                    u32x4 w; w.x = cvt_pk_bf16(v0[0], v0[1]); w.y = cvt_pk_bf16(v0[2], v0[3]); w.z = cvt_pk_bf16(v1[0], v1[1]); w.w = cvt_pk_bf16(v1[2], v1[3]);
                    *(u32x4*)(rowp + bj * 128) = w; } }
    }
};
struct EpiPhy {
    static constexpr bool PERM = true, AFTER_DRAIN = false;
    bf16* O; const float* brow;
    __device__ __forceinline__ void operator()(const f32x4 (&acc)[2][2][4][2], const Unit& u, int wr, int wc, int fr, int fq) const {
        const int row0 = u.pm * 256 + wr * 64 + fr; const int col0 = u.pn * 256 + wc * 32 + 8 * fq;
#pragma unroll
        for (int ai = 0; ai < 2; ++ai)
#pragma unroll
            for (int m = 0; m < 4; ++m) { const int row = row0 + ai * 128 + m * 16; const float b = brow[row]; bf16* rowp = O + (size_t)row * MTOK + col0;
#pragma unroll
                for (int bj = 0; bj < 2; ++bj) { const f32x4 v0 = acc[ai][bj][m][0] + b, v1 = acc[ai][bj][m][1] + b;
                    u32x4 w; w.x = cvt_pk_bf16(v0[0], v0[1]); w.y = cvt_pk_bf16(v0[2], v0[3]); w.z = cvt_pk_bf16(v1[0], v1[1]); w.w = cvt_pk_bf16(v1[2], v1[3]);
                    *(u32x4*)(rowp + bj * 128) = w; } }
    }
};
__device__ __forceinline__ void unpack8(const u32x4 w, float (&f)[8]) {
    f[0] = bf2f(w.x & 0xffffu); f[1] = bf2f(w.x >> 16); f[2] = bf2f(w.y & 0xffffu); f[3] = bf2f(w.y >> 16);
    f[4] = bf2f(w.z & 0xffffu); f[5] = bf2f(w.z >> 16); f[6] = bf2f(w.w & 0xffffu); f[7] = bf2f(w.w >> 16);
}
struct EpiDual {
    static constexpr bool PERM = true, AFTER_DRAIN = false;
    bf16* T1; const bf16* BG;
    static constexpr size_t MG_DELTA = (WS_R5 + 64 * MiB - WS_R1) / 2;
    __device__ __forceinline__ void operator()(const f32x4 (&acc)[2][2][4][2], const Unit& u, int wr, int wc, int fr, int fq) const {
        const int row0 = u.pm * 256 + wr * 64 + fr; const int col0 = u.pn * 256 + wc * 32 + 8 * fq;
#pragma unroll
        for (int ai = 0; ai < 2; ++ai)
#pragma unroll
            for (int m = 0; m < 4; ++m) { const size_t row = (size_t)(row0 + ai * 128 + m * 16);
#pragma unroll
                for (int bj = 0; bj < 2; ++bj) { const int col = col0 + bj * 128;
                    const u32x4 gw = *(const u32x4*)(BG + row * 2048 + (u.sel ? 1024 : 0) + col);
                    float g[8]; unpack8(gw, g);
                    float v[8];
#pragma unroll
                    for (int e = 0; e < 4; ++e) { v[e] = acc[ai][bj][m][0][e] * g[e]; v[4 + e] = acc[ai][bj][m][1][e] * g[4 + e]; }
                    if (u.sel) { const u32x4 tw = *(const u32x4*)(T1 + row * DM + col); float t[8]; unpack8(tw, t);
#pragma unroll
                        for (int e = 0; e < 8; ++e) v[e] += t[e]; }
                    u32x4 w; w.x = cvt_pk_bf16(v[0], v[1]); w.y = cvt_pk_bf16(v[2], v[3]); w.z = cvt_pk_bf16(v[4], v[5]); w.w = cvt_pk_bf16(v[6], v[7]);
                    *(u32x4*)(T1 + (u.sel ? MG_DELTA : (size_t)0) + row * DM + col) = w; } }
    }
};
struct EpiOut {
    static constexpr bool PERM = true, AFTER_DRAIN = false;
    const float* x; float* X1; bf16* A2; float* SS; const float* MOD; const float* g2n;
    __device__ __forceinline__ void operator()(const f32x4 (&acc)[2][2][4][2], const Unit& u, int wr, int wc, int fr, int fq) const {
        const int row0 = u.pm * 256 + wr * 64 + fr; const int col0 = u.pn * 256 + wc * 32 + 8 * fq;
        const int b = (u.pm * 256) >> 12; const float* mod = MOD + b * NMOD;
        f32x4 g1v[2][2], G2v[2][2];
#pragma unroll
        for (int bj = 0; bj < 2; ++bj)
#pragma unroll
            for (int n = 0; n < 2; ++n) { const int c = col0 + bj * 128 + 4 * n; g1v[bj][n] = *(const f32x4*)(mod + 2048 + c);
                const f32x4 gg = *(const f32x4*)(g2n + c), sc = *(const f32x4*)(mod + 4096 + c); G2v[bj][n] = gg * (sc + 1.0f); }
#pragma unroll
        for (int ai = 0; ai < 2; ++ai)
#pragma unroll
            for (int m = 0; m < 4; ++m) { const size_t row = (size_t)(row0 + ai * 128 + m * 16); float ss = 0.f;
#pragma unroll
                for (int bj = 0; bj < 2; ++bj) { const size_t off = row * DM + col0 + bj * 128;
                    const f32x4 xa = *(const f32x4*)(x + off), xb = *(const f32x4*)(x + off + 4);
                    const f32x4 v0 = xa + g1v[bj][0] * acc[ai][bj][m][0], v1 = xb + g1v[bj][1] * acc[ai][bj][m][1];
                    *(f32x4*)(X1 + off) = v0; *(f32x4*)(X1 + off + 4) = v1;
                    ss += (v0[0] * v0[0] + v0[1] * v0[1]) + (v0[2] * v0[2] + v0[3] * v0[3]) + (v1[0] * v1[0] + v1[1] * v1[1]) + (v1[2] * v1[2] + v1[3] * v1[3]);
                    const f32x4 a0 = v0 * G2v[bj][0], a1 = v1 * G2v[bj][1];
                    u32x4 w; w.x = cvt_pk_bf16(a0[0], a0[1]); w.y = cvt_pk_bf16(a0[2], a0[3]); w.z = cvt_pk_bf16(a1[0], a1[1]); w.w = cvt_pk_bf16(a1[2], a1[3]);
                    *(u32x4*)(A2 + off) = w; }
                ss += __shfl_xor(ss, 16); ss += __shfl_xor(ss, 32);
                if (fq == 0) SS[row * 16 + u.pn * 4 + wc] = ss; }
    }
};
struct EpiFfn {
    static constexpr bool PERM = false, AFTER_DRAIN = false;
    const float* SS; const float* B2; bf16* ACT;
    __device__ __forceinline__ void operator()(const f32x4 (&acc)[2][2][4][2], const Unit& u, int wr, int wc, int fr, int fq) const {
        const int row0 = u.pm * 256 + wr * 64 + fr; const int col0 = u.pn * 256 + wc * 32 + 4 * fq;
        const int b = (u.pm * 256) >> 12; const float* b2 = B2 + b * NFF;
        f32x4 bv[2][2];
#pragma unroll
        for (int bj = 0; bj < 2; ++bj)
#pragma unroll
            for (int n = 0; n < 2; ++n) bv[bj][n] = *(const f32x4*)(b2 + col0 + bj * 128 + n * 16);
#pragma unroll
        for (int ai = 0; ai < 2; ++ai)
#pragma unroll
            for (int m = 0; m < 4; ++m) { const size_t row = (size_t)(row0 + ai * 128 + m * 16);
                const f32x4* sp = (const f32x4*)(SS + row * 16); const f32x4 s0 = sp[0], s1 = sp[1], s2 = sp[2], s3 = sp[3];
                const float tot = ((s0[0] + s0[1]) + (s0[2] + s0[3])) + ((s1[0] + s1[1]) + (s1[2] + s1[3])) + ((s2[0] + s2[1]) + (s2[2] + s2[3])) + ((s3[0] + s3[1]) + (s3[2] + s3[3]));
                const float rstd = 1.0f / sqrtf(tot * (1.0f / DM) + RMS_EPS);
#pragma unroll
                for (int bj = 0; bj < 2; ++bj) { const f32x4 g = acc[ai][bj][m][0] * rstd + bv[bj][0], uu = acc[ai][bj][m][1] * rstd + bv[bj][1];
                    const int grp = 8 * u.pn + 4 * bj + wc;
                    u32x2v w; w.x = cvt_pk_bf16(siluf_fast(g[0]) * uu[0], siluf_fast(g[1]) * uu[1]); w.y = cvt_pk_bf16(siluf_fast(g[2]) * uu[2], siluf_fast(g[3]) * uu[3]);
                    *(u32x2v*)(ACT + row * DFF + 16 * grp + 4 * fq) = w; } }
    }
};
struct EpiDown {
    static constexpr bool PERM = false, AFTER_DRAIN = false;
    float* X; float* SS2; const float* MOD;
    __device__ __forceinline__ void operator()(const f32x4 (&acc)[2][2][4][2], const Unit& u, int wr, int wc, int fr, int fq) const {
        const int row0 = u.pm * 256 + wr * 64 + fr; const int col0 = u.pn * 256 + wc * 32 + 4 * fq;
        const int b = (u.pm * 256) >> 12; const float* mod = MOD + b * NMOD;
        f32x4 g2v[2][2];
#pragma unroll
        for (int bj = 0; bj < 2; ++bj)
#pragma unroll
            for (int n = 0; n < 2; ++n) g2v[bj][n] = *(const f32x4*)(mod + 5120 + col0 + bj * 128 + n * 16);
#pragma unroll
        for (int ai = 0; ai < 2; ++ai)
#pragma unroll
            for (int m = 0; m < 4; ++m) { const size_t row = (size_t)(row0 + ai * 128 + m * 16); float ss = 0.f;
#pragma unroll
                for (int bj = 0; bj < 2; ++bj)
#pragma unroll
                    for (int n = 0; n < 2; ++n) { float* p = X + row * DM + col0 + bj * 128 + n * 16;
                        const f32x4 v = *(const f32x4*)p + g2v[bj][n] * acc[ai][bj][m][n]; *(f32x4*)p = v;
                        ss += (v[0] * v[0] + v[1] * v[1]) + (v[2] * v[2] + v[3] * v[3]); }
                ss += __shfl_xor(ss, 16); ss += __shfl_xor(ss, 32);
                if (fq == 0) SS2[row * 16 + u.pn * 4 + wc] = ss; }
    }
};
struct DualOrder {
    pg8::StaticOrder so;
    __device__ __forceinline__ bool next(int i, Unit& u) const { const bool ok = so.next(i >> 1, u); u.sel = i & 1; return ok; }
    __device__ __forceinline__ void a_ready(const Unit&) const {}
    __device__ __forceinline__ void done(const Unit&) const {}
};
typedef short bf16x8s __attribute__((ext_vector_type(8)));
__device__ __forceinline__ f32x4 mfma16(bf16x8s a, bf16x8s b, f32x4 c) { return __builtin_amdgcn_mfma_f32_16x16x32_bf16(a, b, c, 0, 0, 0); }

template <bool BWD, bool CTX>
__device__ __forceinline__ void rnn_pass(Frame& F, int b, int h, int q, float (&cS)[2]) {
    int lane = FLANE;
    asm volatile("" : "+v"(lane));
    const int fr = lane & 15, fq = lane >> 4, w = F.wave;
    constexpr int dir = BWD ? 1 : 0;
    const LAS float* cw = (const LAS float*)F.lds;
    LAS float* tab = (LAS float*)(F.lds + 2048);
    const bf16* RXp = CTX ? (const bf16*)(F.ws + WS_RXC) : (const bf16*)(F.ws + WS_R2);
    bf16* HF = (bf16*)(F.ws + WS_R1); const bf16* RG = (const bf16*)(F.ws + WS_R3); bf16* YO = (bf16*)(F.ws + ((F.flags & 1) ? WS_SCR : WS_R3));
    constexpr int seqlen = CTX ? CTXL : SEQ;
    bf16x8s Wr[2][2], Wi[2][2], Id[2];
    {
        const float* wa = F.in[12] + (size_t)(dir * 16 + h) * 4096; const float* wx = F.in[14] + (size_t)(dir * 16 + h) * 4096;
#pragma unroll
        for (int n = 0; n < 2; ++n) {
            const int j = q * 32 + 16 * n + fr;
#pragma unroll
            for (int ks = 0; ks < 2; ++ks)
#pragma unroll
                for (int jj = 0; jj < 8; ++jj) { const int i = 8 * fq + jj + 32 * ks; Wr[n][ks][jj] = (short)f2bf(wa[i * 64 + j]); Wi[n][ks][jj] = (short)f2bf(wx[i * 64 + j]); }
#pragma unroll
            for (int jj = 0; jj < 8; ++jj) Id[n][jj] = (8 * fq + jj == 16 * n + fr) ? (short)0x3F80 : (short)0;
        }
    }
    float ba_[2], bx_[2], nsp[2];
#pragma unroll
    for (int n = 0; n < 2; ++n) { const int c = h * 64 + q * 32 + 16 * n + fr;
        ba_[n] = F.in[13][dir * 1024 + c]; bx_[n] = F.in[15][dir * 1024 + c];
        const float lam = F.in[16][dir * 1024 + c]; nsp[n] = -8.0f * log1pf(expf(-lam)) * LOG2E; }
    __syncthreads();
    constexpr int nsuper = CTX ? 1 : 8;
    for (int si = 0; si < nsuper; ++si) {
        const int s = BWD ? nsuper - 1 - si : si;
        const int t0 = s * 512 + w * 64;
        const bool active = CTX ? (w < 4) : true;
        float P[4][2][4], Hl[4][2][4], RA[4][2], RH[4][2];
        if (active) {
#pragma unroll
            for (int m = 0; m < 4; ++m) {
                bf16x8s Au[2];
                {
                    const LAS float* cwp = cw; asm volatile("" : "+v"(cwp));
#pragma unroll
                    for (int ks = 0; ks < 2; ++ks) {
                        const int tt = t0 + 16 * m + fr, ci = 32 * ks + 8 * fq;
                        float u8[8];
                        { const f32x4 b0 = *(const LAS f32x4*)(cwp + 256 + ci), b1 = *(const LAS f32x4*)(cwp + 256 + ci + 4);
                          u8[0] = b0[0]; u8[1] = b0[1]; u8[2] = b0[2]; u8[3] = b0[3]; u8[4] = b1[0]; u8[5] = b1[1]; u8[6] = b1[2]; u8[7] = b1[3]; }
#pragma unroll
                        for (int k = 0; k < 4; ++k) {
                            const int off = k - 2;
                            const bool valid = CTX ? (tt + off >= 0 && tt + off < CTXL) : (16 * m + fr + off >= 0 && 16 * m + fr + off < 64);
                            const int tl = valid ? tt + off : tt;
                            const u32x4 rv = *(const u32x4*)(RXp + ((size_t)(b * seqlen + tl)) * DM + h * 64 + ci);
                            float xv[8]; unpack8(rv, xv);
                            f32x4 w0 = *(const LAS f32x4*)(cwp + k * 64 + ci), w1 = *(const LAS f32x4*)(cwp + k * 64 + ci + 4);
                            if (!valid) { w0 = (f32x4){0.f, 0.f, 0.f, 0.f}; w1 = w0; }
                            u8[0] += w0[0] * xv[0]; u8[1] += w0[1] * xv[1]; u8[2] += w0[2] * xv[2]; u8[3] += w0[3] * xv[3];
                            u8[4] += w1[0] * xv[4]; u8[5] += w1[1] * xv[5]; u8[6] += w1[2] * xv[6]; u8[7] += w1[3] * xv[7];
                        }
                        u32x4 pk; pk.x = pk2(u8[0], u8[1]); pk.y = pk2(u8[2], u8[3]); pk.z = pk2(u8[4], u8[5]); pk.w = pk2(u8[6], u8[7]);
                        Au[ks] = __builtin_bit_cast(bf16x8s, pk);
                    }
                }
                const f32x4 z4 = {0.f, 0.f, 0.f, 0.f};
#pragma unroll
                for (int n = 0; n < 2; ++n) {
                    f32x4 aR = mfma16(Au[0], Wr[n][0], z4); aR = mfma16(Au[1], Wr[n][1], aR);
                    f32x4 aI = mfma16(Au[0], Wi[n][0], z4); aI = mfma16(Au[1], Wi[n][1], aI);
                    const f32x4 aU = q ? mfma16(Au[1], Id[n], z4) : mfma16(Au[0], Id[n], z4);
                    float av[4], bv[4];
#pragma unroll
                    for (int e = 0; e < 4; ++e) {
                        const float r = sigmoidf_fast(aR[e] + ba_[n]), ig = sigmoidf_fast(aI[e] + bx_[n]);
                        const float a = __builtin_amdgcn_exp2f(r * nsp[n]);
                        av[e] = a; bv[e] = sqrtf(fmaxf(1.0f - a * a, 0.f)) * ig * aU[e];
                    }
                    if (!BWD) {
                        P[m][n][0] = av[0]; Hl[m][n][0] = bv[0];
#pragma unroll
                        for (int e = 1; e < 4; ++e) { P[m][n][e] = av[e] * P[m][n][e - 1]; Hl[m][n][e] = av[e] * Hl[m][n][e - 1] + bv[e]; }
                        RA[m][n] = P[m][n][3]; RH[m][n] = Hl[m][n][3];
                    } else {
                        P[m][n][3] = av[3]; Hl[m][n][3] = bv[3];
#pragma unroll
                        for (int e = 2; e >= 0; --e) { P[m][n][e] = av[e] * P[m][n][e + 1]; Hl[m][n][e] = av[e] * Hl[m][n][e + 1] + bv[e]; }
                        RA[m][n] = P[m][n][0]; RH[m][n] = Hl[m][n][0];
                    }
                }
            }
        } else {
#pragma unroll
            for (int m = 0; m < 4; ++m)
#pragma unroll
                for (int n = 0; n < 2; ++n) { RA[m][n] = 1.f; RH[m][n] = 0.f;
#pragma unroll
                    for (int e = 0; e < 4; ++e) { P[m][n][e] = 1.f; Hl[m][n][e] = 0.f; } }
        }
        float At[2], Ht[2];
#pragma unroll
        for (int n = 0; n < 2; ++n) {
            float Am[4], Hm[4];
#pragma unroll
            for (int m = 0; m < 4; ++m) {
                float A = RA[m][n], H = RH[m][n];
                const int l1 = BWD ? lane + 16 : lane - 16, l2 = BWD ? lane + 32 : lane - 32;
                { const float A1 = __shfl(A, l1 & 63), H1 = __shfl(H, l1 & 63); const bool ok = BWD ? (fq <= 2) : (fq >= 1); if (ok) { H = A * H1 + H; A = A * A1; } }
                { const float A1 = __shfl(A, l2 & 63), H1 = __shfl(H, l2 & 63); const bool ok = BWD ? (fq <= 1) : (fq >= 2); if (ok) { H = A * H1 + H; A = A * A1; } }
                const int lt = BWD ? fr : fr + 48;
                Am[m] = __shfl(A, lt); Hm[m] = __shfl(H, lt);
                const float Ax = __shfl(A, l1 & 63), Hx = __shfl(H, l1 & 63); const bool okx = BWD ? (fq <= 2) : (fq >= 1);
                RA[m][n] = okx ? Ax : 1.f; RH[m][n] = okx ? Hx : 0.f;
            }
            float cA = 1.f, cH = 0.f;
#pragma unroll
            for (int mi = 0; mi < 4; ++mi) { const int m = BWD ? 3 - mi : mi;
                const float eA = RA[m][n], eH = RH[m][n];
                RA[m][n] = eA * cA; RH[m][n] = eA * cH + eH;
                cH = Am[m] * cH + Hm[m]; cA = Am[m] * cA; }
            At[n] = cA; Ht[n] = cH;
        }
        LAS float* tb = tab + (si & 1) * 512;
        if (fq == 0) {
#pragma unroll
            for (int n = 0; n < 2; ++n) { tb[(w * 32 + 16 * n + fr) * 2 + 0] = At[n]; tb[(w * 32 + 16 * n + fr) * 2 + 1] = Ht[n]; }
        }
        __syncthreads();
        float tin[2];
#pragma unroll
        for (int n = 0; n < 2; ++n) {
            float st = cS[n]; tin[n] = 0.f;
#pragma unroll
            for (int wi = 0; wi < 8; ++wi) { const int ww = BWD ? 7 - wi : wi;
                const float A = tb[(ww * 32 + 16 * n + fr) * 2 + 0], H = tb[(ww * 32 + 16 * n + fr) * 2 + 1];
                if (ww == w) tin[n] = st;
                st = A * st + H; }
            cS[n] = st;
        }
        if (!CTX) {
#pragma unroll
            for (int m = 0; m < 4; ++m)
#pragma unroll
                for (int n = 0; n < 2; ++n) {
                    const float sin_run = RA[m][n] * tin[n] + RH[m][n];
#pragma unroll
                    for (int e = 0; e < 4; ++e) {
                        const float hv = P[m][n][e] * sin_run + Hl[m][n][e];
                        const size_t idx = ((size_t)(b * SEQ + t0 + 16 * m + 4 * fq + e)) * DM + h * 64 + q * 32 + 16 * n + fr;
                        if (!BWD) HF[idx] = (bf16)f2bf(hv);
                        else { const float y = (bf2f(HF[idx]) + hv) * bf2f(RG[idx]); YO[idx] = (bf16)f2bf(y); }
                    }
                }
        }
    }
}

#define OPQ4(v) asm volatile("" : "+v"(v))
template <bool BWD>
__device__ __forceinline__ void rnn_xpass(Frame& F, int task, int b, int h, int q, float (&cS)[2]) {
    int lane = FLANE;
    asm volatile("" : "+v"(lane));
    const int fr = lane & 15, fq = lane >> 4, w = F.wave;
    constexpr int dir = BWD ? 1 : 0;
    LAS float* tab = (LAS float*)(F.lds + 2048);
    bf16x8s Wr[2][2], Wi[2][2], Id[2];
    {
        const float* wa = F.in[12] + (size_t)(dir * 16 + h) * 4096; const float* wx = F.in[14] + (size_t)(dir * 16 + h) * 4096;
#pragma unroll
        for (int n = 0; n < 2; ++n) {
            const unsigned wo = (unsigned)((8 * fq) * 64 + q * 32 + 16 * n + fr);
#pragma unroll
            for (int ks = 0; ks < 2; ++ks) {
#pragma unroll
                for (int jj = 0; jj < 8; ++jj) { const unsigned o = wo + (unsigned)((jj + 32 * ks) * 64); Wr[n][ks][jj] = (short)f2bf(-LOG2E * wa[o]); Wi[n][ks][jj] = (short)f2bf(-LOG2E * wx[o]); }
                OPQ4(Wr[n][ks]); OPQ4(Wi[n][ks]);
            }
#pragma unroll
            for (int jj = 0; jj < 8; ++jj) Id[n][jj] = (8 * fq + jj == 16 * n + fr) ? (short)0x3F80 : (short)0;
            OPQ4(Id[n]);
            asm volatile("" ::: "memory");
        }
    }
    float nba[2], nbx[2], nsp[2];
#pragma unroll
    for (int n = 0; n < 2; ++n) { const int c = h * 64 + q * 32 + 16 * n + fr;
        nba[n] = -LOG2E * F.in[13][dir * 1024 + c]; nbx[n] = -LOG2E * F.in[15][dir * 1024 + c];
        const float lam = F.in[16][dir * 1024 + c]; nsp[n] = -8.0f * log1pf(expf(-lam)) * LOG2E;
        asm volatile("" : "+v"(nba[n]), "+v"(nbx[n]), "+v"(nsp[n])); }
    const bf16* Ub = (const bf16*)(F.ws + WS_R2) + ((size_t)b * SEQ) * DM + h * 64;
    const unsigned aoffb = 2u * (unsigned)(fr * DM + 8 * fq);
    const bf16* RGb = (const bf16*)(F.ws + WS_R3) + ((size_t)b * SEQ) * DM + h * 64 + q * 32;
    bf16* YOb = (bf16*)(F.ws + ((F.flags & 1) ? WS_SCR : WS_R3)) + ((size_t)b * SEQ) * DM + h * 64 + q * 32;
    const unsigned ooffb = 2u * (unsigned)((4 * fq) * DM + fr);
    u32x4* HFp = (u32x4*)(F.ws + WS_R1) + (size_t)task * (64 * 256) + lane;
    __syncthreads();
    bf16x8s Ac[4][2];
    { const int s0 = BWD ? 7 : 0; const bf16* p = Ub + (size_t)(s0 * 512 + w * 64) * DM;
#pragma unroll
      for (int m = 0; m < 4; ++m)
#pragma unroll
        for (int ks = 0; ks < 2; ++ks) Ac[m][ks] = *(const bf16x8s*)((const char*)p + (aoffb + 2u * (unsigned)(m * 16 * DM + 32 * ks))); }
    for (int si = 0; si < 8; ++si) {
        const int s = BWD ? 7 - si : si;
        const int t0 = s * 512 + w * 64;
        unsigned oob = ooffb; asm volatile("" : "+v"(oob));
        float P[4][2][4], Hl[4][2][4], RA[4][2], RH[4][2];
#pragma unroll
        for (int m = 0; m < 4; ++m) {
#pragma unroll
            for (int n = 0; n < 2; ++n) {
                const f32x4 z4 = {0.f, 0.f, 0.f, 0.f};
                f32x4 aR = {nba[n], nba[n], nba[n], nba[n]}; aR = mfma16(Ac[m][0], Wr[n][0], aR); aR = mfma16(Ac[m][1], Wr[n][1], aR);
                f32x4 aI = {nbx[n], nbx[n], nbx[n], nbx[n]}; aI = mfma16(Ac[m][0], Wi[n][0], aI); aI = mfma16(Ac[m][1], Wi[n][1], aI);
                const f32x4 aU = q ? mfma16(Ac[m][1], Id[n], z4) : mfma16(Ac[m][0], Id[n], z4);
                float av[4], bv[4];
#pragma unroll
                for (int e = 0; e < 4; ++e) {
                    const float r = __builtin_amdgcn_rcpf(1.0f + __builtin_amdgcn_exp2f(aR[e]));
                    const float ig = __builtin_amdgcn_rcpf(1.0f + __builtin_amdgcn_exp2f(aI[e]));
                    const float a = __builtin_amdgcn_exp2f(r * nsp[n]);
                    av[e] = a; bv[e] = __builtin_amdgcn_sqrtf(fmaxf(__builtin_fmaf(-a, a, 1.0f), 0.f)) * (ig * aU[e]);
                }
                if (!BWD) {
                    P[m][n][0] = av[0]; Hl[m][n][0] = bv[0];
#pragma unroll
                    for (int e = 1; e < 4; ++e) { P[m][n][e] = av[e] * P[m][n][e - 1]; Hl[m][n][e] = av[e] * Hl[m][n][e - 1] + bv[e]; }
                    RA[m][n] = P[m][n][3]; RH[m][n] = Hl[m][n][3];
                } else {
                    P[m][n][3] = av[3]; Hl[m][n][3] = bv[3];
#pragma unroll
                    for (int e = 2; e >= 0; --e) { P[m][n][e] = av[e] * P[m][n][e + 1]; Hl[m][n][e] = av[e] * Hl[m][n][e + 1] + bv[e]; }
                    RA[m][n] = P[m][n][0]; RH[m][n] = Hl[m][n][0];
                }
            }
            __builtin_amdgcn_sched_barrier(0);
        }
        asm volatile("" ::: "memory");
        { const int sn = si < 7 ? (BWD ? s - 1 : s + 1) : s; const bf16* p = Ub + (size_t)(sn * 512 + w * 64) * DM;
#pragma unroll
          for (int m = 0; m < 4; ++m)
#pragma unroll
            for (int ks = 0; ks < 2; ++ks) Ac[m][ks] = *(const bf16x8s*)((const char*)p + (aoffb + 2u * (unsigned)(m * 16 * DM + 32 * ks))); }
        float At[2], Ht[2];
#pragma unroll
        for (int n = 0; n < 2; ++n) {
            float Am[4], Hm[4];
#pragma unroll
            for (int m = 0; m < 4; ++m) {
                float A = RA[m][n], H = RH[m][n];
                const int l1 = BWD ? lane + 16 : lane - 16, l2 = BWD ? lane + 32 : lane - 32;
                { const float A1 = __shfl(A, l1 & 63), H1 = __shfl(H, l1 & 63); const bool ok = BWD ? (fq <= 2) : (fq >= 1); if (ok) { H = A * H1 + H; A = A * A1; } }
                { const float A1 = __shfl(A, l2 & 63), H1 = __shfl(H, l2 & 63); const bool ok = BWD ? (fq <= 1) : (fq >= 2); if (ok) { H = A * H1 + H; A = A * A1; } }
                const int lt = BWD ? fr : fr + 48;
                Am[m] = __shfl(A, lt); Hm[m] = __shfl(H, lt);
                const float Ax = __shfl(A, l1 & 63), Hx = __shfl(H, l1 & 63); const bool okx = BWD ? (fq <= 2) : (fq >= 1);
                RA[m][n] = okx ? Ax : 1.f; RH[m][n] = okx ? Hx : 0.f;
            }
            float cA = 1.f, cH = 0.f;
#pragma unroll
            for (int mi = 0; mi < 4; ++mi) { const int m = BWD ? 3 - mi : mi;
                const float eA = RA[m][n], eH = RH[m][n];
                RA[m][n] = eA * cA; RH[m][n] = eA * cH + eH;
                cH = Am[m] * cH + Hm[m]; cA = Am[m] * cA; }
            At[n] = cA; Ht[n] = cH;
        }
        LAS float* tb = tab + (si & 1) * 512;
        if (fq == 0) {
#pragma unroll
            for (int n = 0; n < 2; ++n) { tb[(w * 32 + 16 * n + fr) * 2 + 0] = At[n]; tb[(w * 32 + 16 * n + fr) * 2 + 1] = Ht[n]; }
        }
        const bf16* rgp = RGb + (size_t)t0 * DM; bf16* yop = YOb + (size_t)t0 * DM;
        unsigned short rgc[2][4]; u32x4 hfc;
        if (BWD) {
            hfc = HFp[((s * 8 + w) * 4 + 0) * 64];
#pragma unroll
            for (int n = 0; n < 2; ++n)
#pragma unroll
                for (int e = 0; e < 4; ++e) rgc[n][e] = *(const unsigned short*)((const char*)rgp + (oob + 2u * (unsigned)(e * DM + 16 * n)));
        }
        __syncthreads();
        float tin[2];
#pragma unroll
        for (int n = 0; n < 2; ++n) {
            float st = cS[n]; tin[n] = 0.f;
#pragma unroll
            for (int wi = 0; wi < 8; ++wi) { const int ww = BWD ? 7 - wi : wi;
                const float A = tb[(ww * 32 + 16 * n + fr) * 2 + 0], H = tb[(ww * 32 + 16 * n + fr) * 2 + 1];
                if (ww == w) tin[n] = st;
                st = A * st + H; }
            cS[n] = st;
        }
#pragma unroll
        for (int m = 0; m < 4; ++m) {
            unsigned short rgn[2][4]; u32x4 hfn;
            if (BWD && m < 3) {
                hfn = HFp[((s * 8 + w) * 4 + m + 1) * 64];
#pragma unroll
                for (int n = 0; n < 2; ++n)
#pragma unroll
                    for (int e = 0; e < 4; ++e) rgn[n][e] = *(const unsigned short*)((const char*)rgp + (oob + 2u * (unsigned)((16 * (m + 1) + e) * DM + 16 * n)));
            }
            float hv[2][4];
#pragma unroll
            for (int n = 0; n < 2; ++n) {
                const float sin_run = RA[m][n] * tin[n] + RH[m][n];
#pragma unroll
                for (int e = 0; e < 4; ++e) hv[n][e] = P[m][n][e] * sin_run + Hl[m][n][e];
            }
            if (!BWD) {
                u32x4 o; o.x = cvt_pk_bf16(hv[0][0], hv[0][1]); o.y = cvt_pk_bf16(hv[0][2], hv[0][3]); o.z = cvt_pk_bf16(hv[1][0], hv[1][1]); o.w = cvt_pk_bf16(hv[1][2], hv[1][3]);
                HFp[((s * 8 + w) * 4 + m) * 64] = o;
            } else {
                float hf[8]; unpack8(hfc, hf);
#pragma unroll
                for (int n = 0; n < 2; ++n)
#pragma unroll
                    for (int e = 0; e < 4; ++e) { const float y = (hf[4 * n + e] + hv[n][e]) * bf2f(rgc[n][e]);
                        *(bf16*)((char*)yop + (oob + 2u * (unsigned)((16 * m + e) * DM + 16 * n))) = (bf16)f2bf(y); }
                if (m < 3) { hfc = hfn;
#pragma unroll
                    for (int n = 0; n < 2; ++n)
#pragma unroll
                        for (int e = 0; e < 4; ++e) rgc[n][e] = rgn[n][e]; }
            }
        }
    }
}
__device__ __forceinline__ void rnn_task(Frame& F, int task) {
    const int b = task >> 5, h = (task >> 1) & 15, q = task & 1;
    __syncthreads();
    { LAS float* cw = (LAS float*)F.lds; const float* w = F.in[10]; const float* cb = F.in[11];
      for (int idx = FTID; idx < 320; idx += 512) cw[idx] = idx < 256 ? w[(idx >> 6) * DM + h * 64 + (idx & 63)] : cb[h * 64 + (idx - 256)]; }
    __syncthreads();
    float cf_[2] = {0.f, 0.f}, cb_[2] = {0.f, 0.f};
    rnn_pass<false, true>(F, b, h, q, cf_);
    rnn_pass<true, true>(F, b, h, q, cb_);
    rnn_xpass<false>(F, task, b, h, q, cf_);
    rnn_xpass<true>(F, task, b, h, q, cb_);
}
#define HY_SYNC() __syncthreads()
#define OPAQUE_PTR(p) asm volatile("" : "+v"(p))
__device__ __forceinline__ void hy_taps_pass(Frame& F, int grp, int cp, float* KT) {
    const int lane = FLANE, fr = lane & 15, fq = lane >> 4;
    const float* w4 = F.in[26]; const bf16* HDN = (const bf16*)(F.ws + WS_HDN);
    bf16x8s Bw[2];
    { const int pcx = (fr >> 2) & 1, o = (fr >> 1) & 1, dr = fr & 1; const int wcol = o * 2048 + dr * 1024 + 4 * grp + 2 * cp + pcx;
#pragma unroll
      for (int ks = 0; ks < 2; ++ks)
#pragma unroll
        for (int jj = 0; jj < 8; ++jj) { const int j = 8 * fq + jj + 32 * ks; Bw[ks][jj] = fr < 8 ? (short)f2bf(w4[(size_t)j * 4096 + wcol]) : (short)0; } }
    for (int mb = F.wave; mb < 256; mb += 8) {
        const int t = 16 * mb + fr;
        const bf16x8s a0 = *(const bf16x8s*)(HDN + t * 64 + 8 * fq), a1 = *(const bf16x8s*)(HDN + t * 64 + 32 + 8 * fq);
        f32x4 acc = {0.f, 0.f, 0.f, 0.f};
        acc = mfma16(a0, Bw[0], acc); acc = mfma16(a1, Bw[1], acc);
        if (fr < 8) *(f32x4*)(KT + fr * 4096 + 16 * mb + 4 * fq) = acc;
    }
}
__device__ __forceinline__ void hy_filter_spectra(Frame& F, int d, int pc, const float* KT, cf* KF, LAS cf* buf0, LAS cf* buf1, LAS float* red, const FftTw& T) {
    int hb = FTID >> 8, ht = FTID & 255;
    asm volatile("" : "+v"(ht), "+v"(hb));
    const GAS float* kf = (const GAS float*)KT + (pc * 4 + hb * 2 + 0) * 4096 + ht; const GAS float* kb = (const GAS float*)KT + (pc * 4 + hb * 2 + 1) * 4096 - ht;
    OPAQUE_PTR(kf); OPAQUE_PTR(kb);
    GAS cf* kfo = (GAS cf*)KF + (hb * 2) * 16 * 256 + ht; OPAQUE_PTR(kfo);
    const float delta = 3.0701134573253945f + (float)d * (12.280453829301578f / 1023.0f);
    const float dl2 = -delta * LOG2E * (1.0f / 4095.0f);
    cf xe[16], xo[16]; float lsum = 0.f;
    const cf w32 = cmk(0.98078528040323043f, -0.19509032201612825f);
    cf wn = T.wb; FFT_OPAQUE(wn);
#pragma unroll
    for (int n2 = 0; n2 < 16; ++n2) {
        const int n = ht + 256 * n2;
        const float fv = kf[256 * n2] * __builtin_amdgcn_exp2f((float)n * dl2);
        const int nb = n == 0 ? 1 : 4096 - n;
        float bvx = (n2 == 0 ? kb[ht == 0 ? 1 : 4096] : kb[4096 - 256 * n2]) * __builtin_amdgcn_exp2f((float)nb * dl2); if (n == 0) bvx = 0.f;
        lsum += fabsf(fv) + fabsf(bvx);
        xe[n2] = cmk(fv + bvx, 0.f);
        xo[n2] = cmk((fv - bvx) * wn.x, (fv - bvx) * wn.y); wn = cmul(wn, w32);
    }
    lsum = wave_sum(lsum);
    if (FLANE == 0) red[F.wave] = lsum;
    HY_SYNC();
    const float tot = (red[hb * 4 + 0] + red[hb * 4 + 1]) + (red[hb * 4 + 2] + red[hb * 4 + 3]);
    const float scale = 1.0f / (tot * 8192.0f);
#pragma unroll
    for (int i = 0; i < 16; ++i) { xe[i].x *= scale; xe[i].y *= scale; xo[i].x *= scale; xo[i].y *= scale; }
    fft_fA(xe, ht, buf0, T); HY_SYNC(); fft_fB(xe, ht, buf0, buf1, T); HY_SYNC(); fft_fC(xe, ht, buf1);
#pragma unroll
    for (int k2 = 0; k2 < 16; ++k2) kfo[k2 * 256] = xe[k2];
    fft_fA(xo, ht, buf0, T); HY_SYNC(); fft_fB(xo, ht, buf0, buf1, T); HY_SYNC(); fft_fC(xo, ht, buf1);
#pragma unroll
    for (int k2 = 0; k2 < 16; ++k2) kfo[(16 + k2) * 256] = xo[k2];
}
__device__ __forceinline__ float hy_conv3(const GAS bf16* rowp, int t, float w0, float w1, float w2, float bias) {
    const float c = bf2f(rowp[t]);
    const float l = __int_as_float(__builtin_amdgcn_update_dpp(0, __float_as_int(c), 0x138, 0xF, 0xF, false));
    const float r = __int_as_float(__builtin_amdgcn_update_dpp(0, __float_as_int(c), 0x130, 0xF, 0xF, false));
    return bias + w0 * l + w1 * c + w2 * r;
}
__device__ __forceinline__ void hy_pair_task(Frame& F, int d, int bp, const cf* KF, LAS cf* buf0, LAS cf* buf1, const FftTw& T) {
    int ht = FTID & 255;
    asm volatile("" : "+v"(ht));
    bf16* PH = (bf16*)(F.ws + WS_R5);
    const float* cwv = F.in[17]; const float* cbv = F.in[18]; const float* skipv = F.in[27];
    const int b0 = 2 * bp, b1 = 2 * bp + 1;
    cf zr[16];
    {
        const float w0 = cwv[d], w1 = cwv[3072 + d], w2 = cwv[6144 + d], bs = cbv[d];
        const GAS bf16* r0 = (const GAS bf16*)PH + (size_t)d * MTOK + b0 * SEQ; const GAS bf16* r1 = (const GAS bf16*)PH + (size_t)d * MTOK + b1 * SEQ;
        OPAQUE_PTR(r0); OPAQUE_PTR(r1);
#pragma unroll
        for (int n2 = 0; n2 < 16; ++n2) { const int t = ht + 256 * n2; zr[n2] = cmk(hy_conv3(r0, t, w0, w1, w2, bs), hy_conv3(r1, t, w0, w1, w2, bs)); }
    }
    const cf wb = T.wb;
    const cf w32 = cmk(0.98078528040323043f, -0.19509032201612825f);
#pragma unroll 1
    for (int o = 0; o < 2; ++o) {
        cf acc[16];
        {
            cf x[16];
#pragma unroll
            for (int i = 0; i < 16; ++i) x[i] = zr[i];
            fft_fA(x, ht, buf0, T); HY_SYNC(); fft_fB(x, ht, buf0, buf1, T); HY_SYNC(); fft_fC(x, ht, buf1);
            const GAS cf* kp = (const GAS cf*)KF + ((o * 2 + 0) * 16) * 256 + ht; OPAQUE_PTR(kp);
#pragma unroll
            for (int k2 = 0; k2 < 16; ++k2) x[k2] = cmul(x[k2], kp[k2 * 256]);
            fft_iA(x, ht, buf0, T); HY_SYNC(); fft_iB(x, ht, buf0, buf1, T); HY_SYNC(); fft_iC(x, ht, buf1);
#pragma unroll
            for (int i = 0; i < 16; ++i) acc[i] = x[i];
        }
        {
            cf x[16];
            { cf w = wb; FFT_OPAQUE(w);
#pragma unroll
              for (int i = 0; i < 16; ++i) { x[i] = cmul(zr[i], w); w = cmul(w, w32); } }
            fft_fA(x, ht, buf0, T); HY_SYNC(); fft_fB(x, ht, buf0, buf1, T); HY_SYNC(); fft_fC(x, ht, buf1);
            const GAS cf* kp = (const GAS cf*)KF + ((o * 2 + 1) * 16) * 256 + ht; OPAQUE_PTR(kp);
#pragma unroll
            for (int k2 = 0; k2 < 16; ++k2) x[k2] = cmul(x[k2], kp[k2 * 256]);
            fft_iA(x, ht, buf0, T); HY_SYNC(); fft_iB(x, ht, buf0, buf1, T); HY_SYNC(); fft_iC(x, ht, buf1);
            { cf w = cconj(wb); FFT_OPAQUE(w); const cf w32c = cconj(w32);
#pragma unroll
              for (int i = 0; i < 16; ++i) { acc[i] = cadd(acc[i], cmul(x[i], w)); w = cmul(w, w32c); } }
        }
        {
            const int ch = (1 + o) * 1024 + d;
            const float w0 = cwv[ch], w1 = cwv[3072 + ch], w2 = cwv[6144 + ch], bs = cbv[ch], sk = skipv[o * 1024 + d];
            const GAS bf16* r0 = (const GAS bf16*)PH + (size_t)ch * MTOK + b0 * SEQ; const GAS bf16* r1 = (const GAS bf16*)PH + (size_t)ch * MTOK + b1 * SEQ;
            OPAQUE_PTR(r0); OPAQUE_PTR(r1);
#pragma unroll
            for (int n2 = 0; n2 < 16; ++n2) { const int t = ht + 256 * n2;
                const float g0 = hy_conv3(r0, t, w0, w1, w2, bs), g1 = hy_conv3(r1, t, w0, w1, w2, bs);
                zr[n2] = cmk(g0 * (acc[n2].x + sk * zr[n2].x), g1 * (acc[n2].y + sk * zr[n2].y)); }
        }
    }
    { GAS bf16* PHo = (GAS bf16*)(F.ws + ((F.flags & 2) ? WS_R1 : WS_R5)); GAS bf16* y0 = PHo + (size_t)d * MTOK + b0 * SEQ; GAS bf16* y1 = PHo + (size_t)d * MTOK + b1 * SEQ;
      OPAQUE_PTR(y0); OPAQUE_PTR(y1);
#pragma unroll
      for (int n2 = 0; n2 < 16; ++n2) { const int t = ht + 256 * n2; y0[t] = (bf16)f2bf(zr[n2].x); y1[t] = (bf16)f2bf(zr[n2].y); } }
}
__device__ __forceinline__ void hy_group(Frame& F, int grp) {
    const int hb = FTID >> 8;
    const FftTw T = fft_make_tw(FTID & 255);
    LAS cf* buf0 = (LAS cf*)(F.lds + hb * (2 * FFT_BUF_ELEMS * 8)); LAS cf* buf1 = buf0 + FFT_BUF_ELEMS;
    LAS float* red = (LAS float*)(F.lds + SMALL_OFF);
    float* KT = (float*)(F.ws + WS_SCR + (size_t)blockIdx.x * SCR_PER_BLOCK);
    cf* KF = (cf*)(F.ws + WS_SCR + (size_t)blockIdx.x * SCR_PER_BLOCK + 131072);
    for (int cp = 0; cp < 2; ++cp) {
        HY_SYNC();
        hy_taps_pass(F, grp, cp, KT);
        HY_SYNC();
        for (int pc = 0; pc < 2; ++pc) {
            const int d = 4 * grp + 2 * cp + pc;
            if (!(F.flags & 8)) hy_filter_spectra(F, d, pc, KT, KF, buf0, buf1, red, T);
            HY_SYNC();
            if (!(F.flags & 4)) for (int it = 0; it < 2; ++it) hy_pair_task(F, d, 2 * it + hb, KF, buf0, buf1, T);
            HY_SYNC();
        }
    }
}
__device__ __forceinline__ void p4_transpose(Frame& F) {
    const int gw = F.vcu * NWAVES + F.wave, NGW = F.G * NWAVES, lane = FLANE;
    const bf16* YT = (const bf16*)(F.ws + WS_R5); bf16* Y = (bf16*)(F.ws + WS_R2);
    LAS bf16* tile = (LAS bf16*)(F.lds + F.wave * 9216);
    for (int item = gw; item < 16 * 512; item += NGW) {
        const int c0 = (item >> 9) * 64, t0 = (item & 511) * 64;
#pragma unroll
        for (int i = 0; i < 8; ++i) { const int row = i * 8 + (lane >> 3), chunk = lane & 7;
            const u32x4 v = *(const u32x4*)(YT + (size_t)(c0 + row) * MTOK + t0 + 8 * chunk);
            const unsigned ww[4] = {v.x, v.y, v.z, v.w};
#pragma unroll
            for (int e = 0; e < 8; ++e) tile[(8 * chunk + e) * 72 + row] = (bf16)((ww[e >> 1] >> (16 * (e & 1))) & 0xffffu); }
        LDS_WAIT(); asm volatile("" ::: "memory");
#pragma unroll
        for (int i = 0; i < 8; ++i) { const int tok = i * 8 + (lane >> 3), chunk = lane & 7;
            const u32x4 v = *(const LAS u32x4*)(tile + tok * 72 + 8 * chunk);
            *(u32x4*)(Y + (size_t)(t0 + tok) * DM + c0 + 8 * chunk) = v; }
        LDS_WAIT(); asm volatile("" ::: "memory");
    }
}
__device__ __forceinline__ void p9_final(Frame& F) {
    const int gw = F.vcu * NWAVES + F.wave, NGW = F.G * NWAVES, lane = FLANE;
    const float* SS2 = (const float*)(F.ws + WS_SS2); const float* fg = F.in[33];
    for (int m = gw; m < MTOK; m += NGW) {
        float s = SS2[(size_t)m * 16 + (lane & 15)];
        s += __shfl_xor(s, 1); s += __shfl_xor(s, 2); s += __shfl_xor(s, 4); s += __shfl_xor(s, 8);
        const float rstd = 1.0f / sqrtf(s * (1.0f / DM) + RMS_EPS);
        GAS f32x4* xr = (GAS f32x4*)(F.out + (size_t)m * DM) + lane;
#pragma unroll
        for (int j = 0; j < 4; ++j) { const f32x4 g = ((const GAS f32x4*)fg)[64 * j + lane]; const f32x4 v = xr[64 * j]; xr[64 * j] = v * rstd * g; }
    }
}
#ifndef MK_DOUBLE_MASK
#define MK_DOUBLE_MASK 0
#endif
#define MK_P3_DRY 0
struct Args { const float* in[34]; float* out; unsigned char* ws; int ph_lo, ph_hi, flags, pad; };
__global__ void __launch_bounds__(NWAVES * 64, 2) mk_fwd(Args args) {
    extern __shared__ __attribute__((aligned(16))) unsigned char lds_raw[];
    Frame F;
    F.lds = (LAS unsigned char*)lds_raw;
    F.wave = __builtin_amdgcn_readfirstlane(threadIdx.x >> 6);
    F.G = gridDim.x; { const int bx = blockIdx.x; F.vcu = (F.G % 8 == 0) ? (bx % 8) * (F.G / 8) + bx / 8 : bx; }
    F.in = args.in; F.out = args.out; F.ws = args.ws; F.flags = args.flags;
    unsigned char* ws = args.ws;
    volatile LAS unsigned* MISC = (volatile LAS unsigned*)(F.lds + MISC_OFF);
    for (int u = FTID; u < (LDS_BYTES - MISC_OFF) / 4; u += NWAVES * 64) ((LAS unsigned*)(F.lds + MISC_OFF))[u] = 0u;
    __syncthreads();
    XcdBarrier bar; bar.wave = F.wave; bar.bar = (unsigned*)(ws + WS_CTL) + CW_BAR; bar.x = 0; bar.st = nullptr;
    if (MK_N_LAUNCHES == 1) bar = xcd_barrier_post((unsigned*)(ws + WS_CTL) + CW_BAR, MISC + 8, F.wave);
    const int lo = args.ph_lo, hi = args.ph_hi;
#ifndef MK_PHASE_MASK
#define MK_PHASE_MASK 0x3ff
#endif
#define IN(k) (((MK_PHASE_MASK >> (k)) & 1) && lo <= (k) && (k) < hi)
#define SEAM(k) do { if (IN(k) && IN((k) + 1)) xcd_barrier(bar); } while (0)

    if (IN(0)) { p0_prologue(F); } SEAM(0);
    if (IN(1)) { p1_phase(F); } SEAM(1);
    if (IN(2)) {
        const bf16* XN = (const bf16*)(ws + WS_R1); const bf16* WIN = (const bf16*)(ws + WS_WIN_T);
        {
            pg8::Gemm g{XN, WIN, XN, WIN, MTOK, 4096, DM}; pg8::StaticOrder S; S.init(MTOK, 4096, F.G, (int)blockIdx.x);
            EpiIn<true> E{(bf16*)(ws + WS_R2), (bf16*)(ws + WS_R3), (bf16*)F.out, (const float*)(ws + WS_BINP), F.in[10], F.in[11]};
            pg8::gemm_phase<EpiIn<true>, pg8::StaticOrder, true, true>(F.lds, g, S, E, F.wave);
        }
        {
            pg8::Gemm g{WIN + (size_t)4096 * DM, XN, WIN + (size_t)4096 * DM, XN, 3072, MTOK, DM}; pg8::StaticOrder S; S.init(3072, MTOK, F.G, (int)blockIdx.x);
            EpiPhy E{(bf16*)(ws + WS_R5), (const float*)(ws + WS_BINP) + 4096};
            pg8::gemm_phase<EpiPhy, pg8::StaticOrder, true, true>(F.lds, g, S, E, F.wave);
        }
        {
            const bf16* XC = (const bf16*)(ws + WS_XC);
            pg8::Gemm g{XC, WIN, XC, WIN, MCTX, DM, DM}; pg8::StaticOrder S; S.init(MCTX, DM, F.G, (int)blockIdx.x);
            EpiIn<false> E{(bf16*)(ws + WS_RXC), nullptr, nullptr, (const float*)(ws + WS_BINP), nullptr, nullptr};
            pg8::gemm_phase<EpiIn<false>, pg8::StaticOrder, true, true>(F.lds, g, S, E, F.wave);
        }
    } SEAM(2);
    if (IN(3)) {
#ifndef MK_NO_RNN
        if (!(F.flags & 2)) for (int task = blockIdx.x; task < 256; task += F.G) rnn_task(F, task);
#endif
#ifndef MK_NO_HY
        if (!(F.flags & 1)) for (int grp = blockIdx.x; grp < 256; grp += F.G) hy_group(F, grp);
#endif
    } SEAM(3);
    if (IN(4)) { p4_transpose(F); } SEAM(4);
    if (IN(5)) {
        pg8::Gemm g{(const bf16*)(ws + WS_R3), (const bf16*)(ws + WS_WA_T), (const bf16*)(ws + WS_R2), (const bf16*)(ws + WS_WB_T), MTOK, DM, DM};
        DualOrder S; S.so.init(MTOK, DM, F.G, (int)blockIdx.x);
        EpiDual E{(bf16*)(ws + WS_R1), (const bf16*)F.out};
        pg8::gemm_phase<EpiDual, DualOrder, true, true>(F.lds, g, S, E, F.wave);
    } SEAM(5);
    if (IN(6)) {
        const bf16* MG = (const bf16*)(ws + WS_R5 + 64 * MiB); const bf16* WO = (const bf16*)(ws + WS_WOUT_T);
        pg8::Gemm g{MG, WO, MG, WO, MTOK, DM, DM}; pg8::StaticOrder S; S.init(MTOK, DM, F.G, (int)blockIdx.x);
        EpiOut E{F.in[0], F.out, (bf16*)(ws + WS_R1), (float*)(ws + WS_SS), (const float*)(ws + WS_MOD), F.in[7]};
        pg8::gemm_phase<EpiOut, pg8::StaticOrder, true, true>(F.lds, g, S, E, F.wave);
    } SEAM(6);
    if (IN(7)) {
        const bf16* A2 = (const bf16*)(ws + WS_R1); const bf16* WF = (const bf16*)(ws + WS_WFFI_T);
        pg8::Gemm g{A2, WF, A2, WF, MTOK, NFF, DM}; pg8::StaticOrder S; S.init(MTOK, NFF, F.G, (int)blockIdx.x);
        EpiFfn E{(const float*)(ws + WS_SS), (const float*)(ws + WS_BIAS2P), (bf16*)(ws + WS_R5)};
        pg8::gemm_phase<EpiFfn, pg8::StaticOrder, true, true>(F.lds, g, S, E, F.wave);
    } SEAM(7);
    if (IN(8)) {
        const bf16* AC = (const bf16*)(ws + WS_R5); const bf16* WF = (const bf16*)(ws + WS_WFFO_T);
        pg8::Gemm g{AC, WF, AC, WF, MTOK, DM, DFF}; pg8::StaticOrder S; S.init(MTOK, DM, F.G, (int)blockIdx.x);
        EpiDown E{F.out, (float*)(ws + WS_SS2), (const float*)(ws + WS_MOD)};
        pg8::gemm_phase<EpiDown, pg8::StaticOrder, true, true>(F.lds, g, S, E, F.wave);
    } SEAM(8);
    if (IN(9)) { p9_final(F); }
#undef IN
#undef SEAM
}

extern "C" void kernel_launch(void* const* d_in, const int* in_sizes, int n_in, void* d_out, int out_size, void* d_ws, size_t ws_size, hipStream_t stream) {
    static int grid = 0;
    if (grid == 0) {
        if (n_in != 34 || out_size != MTOK * DM || ws_size < WS_END) { fprintf(stderr, "kernel_launch: unexpected shapes (n_in %d, out %d, ws %zu)\n", n_in, out_size, ws_size); grid = -1; return; }
        int dev = 0, cus = 0, per_cu = 0;
        if (hipGetDevice(&dev) != hipSuccess || hipDeviceGetAttribute(&cus, hipDeviceAttributeMultiprocessorCount, dev) != hipSuccess) { grid = -1; return; }
        if (hipFuncSetAttribute((const void*)mk_fwd, hipFuncAttributeMaxDynamicSharedMemorySize, LDS_BYTES) != hipSuccess) { fprintf(stderr, "kernel_launch: hipFuncSetAttribute failed\n"); grid = -1; return; }
        if (hipOccupancyMaxActiveBlocksPerMultiprocessor(&per_cu, (const void*)mk_fwd, NWAVES * 64, LDS_BYTES) != hipSuccess || per_cu < 1)
            fprintf(stderr, "kernel_launch: occupancy query reports %d workgroups per CU\n", per_cu);
        (void)hipGetLastError();
        grid = cus;
    }
    if (grid < 0) return;
    if (hipMemsetAsync((char*)d_ws + WS_CTL, 0, CTL_ZERO_BYTES, stream) != hipSuccess) { fprintf(stderr, "kernel_launch: hipMemsetAsync failed\n"); return; }
    Args a{};
    for (int i = 0; i < 34; ++i) a.in[i] = (const float*)d_in[i];
    a.out = (float*)d_out; a.ws = (unsigned char*)d_ws;
    if (MK_N_LAUNCHES == 1) {
        a.ph_lo = 0; a.ph_hi = N_PHASES;
        hipLaunchKernelGGL(mk_fwd, dim3(grid), dim3(NWAVES * 64), LDS_BYTES, stream, a);
    } else {
        for (int p = 0; p < N_PHASES; ++p) { a.ph_lo = p; a.ph_hi = p + 1;
            if (p == 3 && (MK_P3_DRY & 1)) { a.flags = 1; hipLaunchKernelGGL(mk_fwd, dim3(grid), dim3(NWAVES * 64), LDS_BYTES, stream, a); a.flags = 0; }
            if (p == 3 && (MK_P3_DRY & 2)) { a.flags = (MK_P3_DRY & 0xE); hipLaunchKernelGGL(mk_fwd, dim3(grid), dim3(NWAVES * 64), LDS_BYTES, stream, a); a.flags = 0; }
            for (int r = 0; r < (((MK_DOUBLE_MASK >> p) & 1) ? 2 : 1); ++r) hipLaunchKernelGGL(mk_fwd, dim3(grid), dim3(NWAVES * 64), LDS_BYTES, stream, a); }
    }
}
```
